# Optimizing an MI355X kernel written in HIP

```python
import jax, jax.numpy as jnp
from jax import lax
import numpy as np

D_MODEL = 1024
BATCH = 32
SEQ = 256
DEPTH = 4
DEC_BATCH = 4
DEC_SEQ = 4096
PAST_LEN = 256

GRID_W = 64
MIX_W = D_MODEL
BRANCH_W = MIX_W // 2
H_A = 4
DK_A = BRANCH_W // (2 * H_A)
DV_A = BRANCH_W // H_A
GATE_RANK = 16
GATE_NORMALIZER = 16.0
CHUNK_A = 64
H_B = 4
DH_B = BRANCH_W // H_B
CHUNK_B = 128
POOL_WINDOWS = (2, 4, 8, 16)
G_C = 4
DG_C = BRANCH_W // G_C
CONV_W = 3
N_EVEN = (DEPTH + 1) // 2
N_ODD = DEPTH // 2
EVEN_SPLITS = (H_A * DK_A, H_A * DK_A, BRANCH_W, BRANCH_W, GATE_RANK, GATE_RANK,
               BRANCH_W, BRANCH_W, BRANCH_W)
EVEN_IN = sum(EVEN_SPLITS)
ODD_SPLITS = (BRANCH_W,) * 6
ODD_IN = sum(ODD_SPLITS)
EPS = 1e-6

kernel_name = 'hybrid_gla_sgu_pool_conv_diffusion_step'


def split_cols(z, sizes):
    idx = np.cumsum(sizes)[:-1].tolist()
    return jnp.split(z, idx, axis=-1)


def rmsnorm(x, g):
    xf = x.astype(jnp.float32)
    y = xf * lax.rsqrt(jnp.mean(xf * xf, axis=-1, keepdims=True) + EPS)
    return (y * g.astype(jnp.float32)).astype(x.dtype)


def adaln(cond, w, b):
    m = jax.nn.silu(cond) @ w + b
    shift, scale, gate = jnp.split(m, 3, axis=-1)
    return shift[:, None], scale[:, None], gate[:, None]


def to_col_major(x, rows):
    B, T, C = x.shape
    return x.reshape(B, rows, GRID_W, C).transpose(0, 2, 1, 3).reshape(B, T, C)


def from_col_major(x, rows):
    B, T, C = x.shape
    return x.reshape(B, GRID_W, rows, C).transpose(0, 2, 1, 3).reshape(B, T, C)


def gla_scan(q, k, v, g, s0):
    dt = v.dtype
    B, T, H, DK = q.shape
    DV = v.shape[-1]
    n = T // CHUNK_A

    def chunks(a):
        return a.astype(jnp.float32).reshape(B, n, CHUNK_A, H, a.shape[-1]).swapaxes(0, 1)

    tri = jnp.tril(jnp.ones((CHUNK_A, CHUNK_A), bool))[None, :, :, None, None]

    def step(S, inp):
        qc, kc, vc, gc = inp
        b = jnp.cumsum(gc, axis=1)
        o_inter = jnp.einsum('bihk,bhkv->bihv', qc * jnp.exp(b), S)
        diff = b[:, :, None] - b[:, None]
        decay = jnp.where(tri, jnp.exp(jnp.where(tri, diff, 0.0)), 0.0)
        att = jnp.einsum('bihk,bjhk,bijhk->bhij', qc, kc, decay)
        o_intra = jnp.einsum('bhij,bjhv->bihv', att, vc)
        b_last = b[:, -1]
        S = jnp.exp(b_last)[..., None] * S + jnp.einsum(
            'bjhk,bjhv->bhkv', kc * jnp.exp(b_last[:, None] - b), vc)
        return S, o_inter + o_intra

    S, o = lax.scan(step, s0.astype(jnp.float32), (chunks(q), chunks(k), chunks(v), chunks(g)))
    o = o.swapaxes(0, 1).reshape(B, T, H, DV)
    return o.astype(dt), S.astype(dt)


def centred_mean(x, w):
    B, T, C = x.shape
    cs = jnp.concatenate([jnp.zeros((B, 1, C), jnp.float32),
                          jnp.cumsum(x.astype(jnp.float32), axis=1)], axis=1)
    t = jnp.arange(T)
    lo = jnp.clip(t - w // 2, 0, T)
    hi = jnp.clip(t + w - w // 2, 0, T)
    s = jnp.take(cs, hi, axis=1) - jnp.take(cs, lo, axis=1)
    cnt = (hi - lo).astype(jnp.float32)
    return (s / cnt[None, :, None]).astype(x.dtype)


def setup_inputs(seed: int = 0) -> dict:
    key = jax.random.key(seed)
    ks = jax.random.split(key, 24)
    f32 = jnp.float32
    nrm = lambda k, shape, s: jax.random.normal(k, shape, f32) * s
    return {
        'x_prompt': nrm(ks[0], (BATCH, SEQ, D_MODEL), 1.0),
        'x_sample': nrm(ks[1], (DEC_BATCH, DEC_SEQ, D_MODEL), 1.0),
        'c': nrm(ks[2], (DEC_BATCH, D_MODEL), 1.0),
        'state_gla': nrm(ks[3], (DEC_BATCH, N_EVEN, 2, H_A, DK_A, DV_A), 1.0),
        'c_ctx': nrm(ks[4], (D_MODEL,), 1.0),
        'w_ada': nrm(ks[5], (DEPTH, D_MODEL, 3 * D_MODEL), 0.2 * D_MODEL ** -0.5),
        'b_ada': nrm(ks[6], (DEPTH, 3 * D_MODEL), 0.02),
        'norm_g': 1.0 + nrm(ks[7], (DEPTH, D_MODEL), 0.02),
        'w_in_even': nrm(ks[8], (N_EVEN, D_MODEL, EVEN_IN), D_MODEL ** -0.5),
        'w_in_odd': nrm(ks[9], (N_ODD, D_MODEL, ODD_IN), D_MODEL ** -0.5),
        'w_out': nrm(ks[10], (DEPTH, MIX_W, D_MODEL), 0.5 * MIX_W ** -0.5),
        'w_gk': nrm(ks[11], (N_EVEN, 2, GATE_RANK, H_A * DK_A), GATE_RANK ** -0.5),
        'b_gk': nrm(ks[12], (N_EVEN, 2, H_A * DK_A), 0.1),
        'gla_norm_g': 1.0 + nrm(ks[13], (N_EVEN, DV_A), 0.02),
        'sgu_norm_g': 1.0 + nrm(ks[14], (N_EVEN, BRANCH_W), 0.02),
        'w_s': nrm(ks[15], (N_EVEN, H_B, CHUNK_B, CHUNK_B), CHUNK_B ** -0.5),
        'b_s': 1.0 + nrm(ks[16], (N_EVEN, H_B, CHUNK_B), 0.1),
        'w_pool': nrm(ks[17], (N_ODD, G_C, DG_C, DG_C), DG_C ** -0.5),
        'pool_scale': 1.0 + nrm(ks[18], (N_ODD, BRANCH_W), 0.1),
        'w_conv': nrm(ks[19], (N_ODD, CONV_W, BRANCH_W), CONV_W ** -0.5),
        'final_norm_g': 1.0 + nrm(ks[20], (D_MODEL,), 0.02),
    }


def reference(x_prompt, x_sample, c, state_gla, c_ctx, w_ada, b_ada, norm_g, w_in_even,
              w_in_odd, w_out, w_gk, b_gk, gla_norm_g, sgu_norm_g, w_s, b_s, w_pool,
              pool_scale, w_conv, final_norm_g):

    def mix_even(z, j, s0_f, s0_b):
        B, T, _ = z.shape
        q, k, v, ga, lr_f, lr_b, u, vs, gb = split_cols(z, EVEN_SPLITS)
        q = q.reshape(B, T, H_A, DK_A) * (DK_A ** -0.5)
        k = k.reshape(B, T, H_A, DK_A)
        v = v.reshape(B, T, H_A, DV_A)

        def log_decay(lr, d):
            gl = (lr @ w_gk[j, d] + b_gk[j, d]).astype(jnp.float32)
            return (jax.nn.log_sigmoid(gl) / GATE_NORMALIZER).reshape(B, T, H_A, DK_A)

        flip = lambda a: a[:, ::-1]
        o_f, s_f = gla_scan(q, k, v, log_decay(lr_f, 0), s0_f)
        o_r, s_b = gla_scan(flip(q), flip(k), flip(v), flip(log_decay(lr_b, 1)), s0_b)
        o = o_f + flip(o_r)
        o_a = rmsnorm(o, gla_norm_g[j]).reshape(B, T, BRANCH_W) * jax.nn.silu(ga)
        n = T // CHUNK_B
        vs = rmsnorm(vs, sgu_norm_g[j]).reshape(B, n, CHUNK_B, H_B, DH_B)
        sp = jnp.einsum('hij,bnjhd->bnihd', w_s[j], vs) + b_s[j].T[None, None, :, :, None]
        o_b = u * sp.reshape(B, T, BRANCH_W) * jax.nn.silu(gb)
        return jnp.concatenate([o_a, o_b], axis=-1), s_f, s_b

    def mix_odd(z, j):
        B, T, _ = z.shape
        xc, gc, xd, bd, cd, gd = split_cols(z, ODD_SPLITS)
        pooled = jnp.concatenate(
            [centred_mean(xc[..., i * DG_C:(i + 1) * DG_C], w) for i, w in enumerate(POOL_WINDOWS)],
            axis=-1) - xc
        pooled = jnp.einsum('btgc,gcd->btgd', pooled.reshape(B, T, G_C, DG_C), w_pool[j])
        o_c = pooled.reshape(B, T, BRANCH_W) * pool_scale[j] * jax.nn.silu(gc)
        u = cd * xd
        up = jnp.pad(u, ((0, 0), (1, 1), (0, 0)))
        y = up[:, :-2] * w_conv[j, 0] + up[:, 1:-1] * w_conv[j, 1] + up[:, 2:] * w_conv[j, 2]
        o_d = bd * y * jax.nn.silu(gd)
        return jnp.concatenate([o_c, o_d], axis=-1)

    def run_stream(x, cond, gla_init, rows, latent):
        finals = []
        for l in range(DEPTH):
            shift, scale, gate = adaln(cond, w_ada[l], b_ada[l])
            h = rmsnorm(x, norm_g[l]) * (1.0 + scale) + shift
            col = latent and (l // 2) % 2 == 1
            if col:
                h = to_col_major(h, rows)
            j = l // 2
            if l % 2 == 0:
                out, s_f, s_b = mix_even(h @ w_in_even[j], j, gla_init[j][0], gla_init[j][1])
                finals.append(jnp.stack([s_f, s_b], axis=1))
            else:
                out = mix_odd(h @ w_in_odd[j], j)
            out = out @ w_out[l]
            if col:
                out = from_col_major(out, rows)
            x = x + gate * out
        return rmsnorm(x, final_norm_g), finals

    Bp = x_prompt.shape[0]
    zero_s = jnp.zeros((Bp, H_A, DK_A, DV_A), x_prompt.dtype)
    ctx_init = [(zero_s, zero_s) for _ in range(N_EVEN)]
    y_prompt, finals = run_stream(x_prompt, c_ctx[None], ctx_init, 0, False)
    new_state_gla = jnp.stack(finals, axis=1)

    rows = x_sample.shape[1] // GRID_W
    lat_init = [(state_gla[:, j, 0], state_gla[:, j, 1]) for j in range(N_EVEN)]
    y_sample, _ = run_stream(x_sample, c, lat_init, rows, True)

    return (y_prompt, y_sample, new_state_gla)
```

```cpp
#include <hip/hip_runtime.h>
#include <hip/hip_cooperative_groups.h>
#include <stdint.h>
#include <stdio.h>
namespace cg = cooperative_groups;

#ifndef MEGA
#define MEGA 1
#endif

typedef unsigned short bf16_t;
typedef short bf16x8 __attribute__((ext_vector_type(8)));
typedef float f32x4 __attribute__((ext_vector_type(4)));

constexpr int NTOK = 24576;
constexpr int NPROMPT = 8192;
constexpr int DM = 1024;
constexpr int ZS_E = 3104, ZS_O = 3072, NPAD_E = 3328;
constexpr float EPS = 1e-6f;
constexpr int LDS_BYTES = 155648;
constexpr int NCH = 192;

constexpr size_t WS_ADA = 0;
constexpr size_t WS_DEC = 262144;
constexpr size_t WS_WINE = 1048576;
constexpr size_t WS_WINO = WS_WINE + 2ull * 3328 * 1024 * 2;
constexpr size_t WS_WOUT = WS_WINO + 2ull * 3072 * 1024 * 2;
constexpr size_t WS_Z = 36700160;
constexpr size_t WS_H = 190840832;

struct Params {
  const float *x_prompt, *x_sample, *c, *state_gla, *c_ctx, *w_ada, *b_ada, *norm_g, *w_in_even, *w_in_odd, *w_out, *w_gk, *b_gk,
      *gla_norm_g, *sgu_norm_g, *w_s, *b_s, *w_pool, *pool_scale, *w_conv, *final_norm_g;
  float* out;
  char* ws;
};

__shared__ __attribute__((aligned(1024))) char g_smem[LDS_BYTES];

__device__ __forceinline__ float bf2f(bf16_t b) { return __uint_as_float(((uint32_t)b) << 16); }
__device__ __forceinline__ float bflo(uint32_t w) { return __uint_as_float(w << 16); }
__device__ __forceinline__ float bfhi(uint32_t w) { return __uint_as_float(w & 0xffff0000u); }
__device__ __forceinline__ bf16_t f2bf(float f) { uint32_t u = __float_as_uint(f); u += 0x7fffu + ((u >> 16) & 1u); return (bf16_t)(u >> 16); }
__device__ __forceinline__ uint32_t pk2(float lo, float hi) { uint32_t r; asm("v_cvt_pk_bf16_f32 %0, %1, %2" : "=v"(r) : "v"(lo), "v"(hi)); return r; }
__device__ __forceinline__ float silu_f(float x) { return x / (1.f + __expf(-x)); }
__device__ __forceinline__ float logsig(float x) { return fminf(x, 0.f) - __logf(1.f + __expf(-fabsf(x))); }
__device__ __forceinline__ bf16_t bfel(const uint4& v, int e) { uint32_t w = (e >> 1) == 0 ? v.x : (e >> 1) == 1 ? v.y : (e >> 1) == 2 ? v.z : v.w; return (bf16_t)((e & 1) ? (w >> 16) : (w & 0xffffu)); }

__device__ __forceinline__ void chunk_info(int cidx, int& base, int& T, int& C) {
  if (cidx < 64) { C = cidx & 1; T = 256; base = (cidx >> 1) * 256; }
  else { int cs = cidx - 64; C = cs & 31; T = 4096; base = NPROMPT + (cs >> 5) * 4096; }
}
__device__ __forceinline__ int tok_of(int base, int p, bool colm) { return base + (colm ? ((p & 63) * 64 + (p >> 6)) : p); }
__device__ __forceinline__ int cond_of(int row) { return row < NPROMPT ? 0 : 1 + ((row - NPROMPT) >> 12); }

__device__ __forceinline__ int otid() { int t = threadIdx.x; asm volatile("" : "+v"(t)); return t; }
__device__ __forceinline__ int obid() { int b = blockIdx.x; asm volatile("" : "+s"(b)); return b; }
__device__ __forceinline__ int ogdim() { int b = gridDim.x; asm volatile("" : "+s"(b)); return b; }

#define MFMA16(a, b, c) __builtin_amdgcn_mfma_f32_16x16x32_bf16((a), (b), (c), 0, 0, 0)

__device__ __forceinline__ int src_col_even(int n) {
  if (n < 1024) return n;
  if (n < 1536) return 1568 + (n - 1024);
  if (n < 2048) return 1024 + (n - 1536);
  if (n < 2560) return 2080 + (n - 2048);
  if (n < 3072) return 2592 + (n - 2560);
  if (n < 3104) return 1536 + (n - 3072);
  return -1;
}
__device__ __forceinline__ int src_col_odd(int n) {
  if (n >= 1024 && n < 1536) return n + 512;
  if (n >= 1536 && n < 2048) return n - 512;
  return n;
}

__device__ void prep_phase(const Params& p) {
  const int tid = otid();
  char* smem = g_smem;
  constexpr int N_ADA = 192, N_TR = 4224;
  for (int item = obid(); item < N_ADA + N_TR; item += ogdim()) {
    if (item < N_ADA) {
      const int l = item / 48, n0 = (item % 48) * 64;
      float* SC = (float*)smem;
      float* RED = (float*)(smem + 20480);
      for (int i = tid; i < 5120; i += 512) {
        int cb = i >> 10, k = i & 1023;
        float v = cb == 0 ? p.c_ctx[k] : p.c[(cb - 1) * 1024 + k];
        SC[i] = silu_f(v);
      }
      __syncthreads();
      const int col = tid & 63, ks = tid >> 6;
      float a0 = 0, a1 = 0, a2 = 0, a3 = 0, a4 = 0;
      const float* w = p.w_ada + (size_t)l * 1024 * 3072 + n0 + col;
#pragma unroll 8
      for (int kk = 0; kk < 128; ++kk) {
        int k = ks * 128 + kk;
        float wv = w[(size_t)k * 3072];
        a0 += SC[k] * wv; a1 += SC[1024 + k] * wv; a2 += SC[2048 + k] * wv; a3 += SC[3072 + k] * wv; a4 += SC[4096 + k] * wv;
      }
      RED[(ks * 5 + 0) * 64 + col] = a0; RED[(ks * 5 + 1) * 64 + col] = a1; RED[(ks * 5 + 2) * 64 + col] = a2;
      RED[(ks * 5 + 3) * 64 + col] = a3; RED[(ks * 5 + 4) * 64 + col] = a4;
      __syncthreads();
      if (tid < 320) {
        int cb = tid >> 6, cc = tid & 63;
        float s = p.b_ada[l * 3072 + n0 + cc];
        for (int q = 0; q < 8; ++q) s += RED[(q * 5 + cb) * 64 + cc];
        ((float*)(p.ws + WS_ADA))[(l * 5 + cb) * 3072 + n0 + cc] = s;
      }
      __syncthreads();
    } else {
      int t = item - N_ADA;
      const float* src; bf16_t* dst; int nsrc, kind, nt, kt;
      if (t < 1664) { int j = t / 832, r = t % 832; nt = r >> 4; kt = r & 15; src = p.w_in_even + (size_t)j * 1024 * 3104; nsrc = 3104; dst = (bf16_t*)(p.ws + WS_WINE) + (size_t)j * NPAD_E * 1024; kind = 0; }
      else if (t < 3200) { int tt = t - 1664; int j = tt / 768, r = tt % 768; nt = r >> 4; kt = r & 15; src = p.w_in_odd + (size_t)j * 1024 * 3072; nsrc = 3072; dst = (bf16_t*)(p.ws + WS_WINO) + (size_t)j * 3072 * 1024; kind = 1; }
      else { int tt = t - 3200; int l = tt >> 8, r = tt & 255; nt = r >> 4; kt = r & 15; src = p.w_out + (size_t)l * 1024 * 1024; nsrc = 1024; dst = (bf16_t*)(p.ws + WS_WOUT) + (size_t)l * 1024 * 1024; kind = 2; }
      float* T = (float*)smem;
      const int n0 = nt * 64, k0 = kt * 64;
      {
        const int c4 = tid & 15, kr = tid >> 4;
        const int nn = n0 + c4 * 4;
        const int sc = kind == 0 ? src_col_even(nn) : kind == 1 ? src_col_odd(nn) : nn;
#pragma unroll
        for (int ps = 0; ps < 2; ++ps) {
          int k = kr + ps * 32;
          f32x4 v = {0.f, 0.f, 0.f, 0.f};
          if (sc >= 0) v = *(const f32x4*)(src + (size_t)(k0 + k) * nsrc + sc);
          T[k * 65 + c4 * 4 + 0] = v[0]; T[k * 65 + c4 * 4 + 1] = v[1]; T[k * 65 + c4 * 4 + 2] = v[2]; T[k * 65 + c4 * 4 + 3] = v[3];
        }
      }
      __syncthreads();
      {
        const int n = tid >> 3, kc = tid & 7;
        uint4 o;
        o.x = pk2(T[(kc * 8 + 0) * 65 + n], T[(kc * 8 + 1) * 65 + n]);
        o.y = pk2(T[(kc * 8 + 2) * 65 + n], T[(kc * 8 + 3) * 65 + n]);
        o.z = pk2(T[(kc * 8 + 4) * 65 + n], T[(kc * 8 + 5) * 65 + n]);
        o.w = pk2(T[(kc * 8 + 6) * 65 + n], T[(kc * 8 + 7) * 65 + n]);
        *(uint4*)(dst + (size_t)(n0 + n) * 1024 + k0 + kc * 8) = o;
      }
      __syncthreads();
    }
  }
}

__device__ void norm_phase(const Params& p, int l) {
  const int tid = otid(), lane = tid & 63, wid = tid >> 6;
  const float* ada = (const float*)(p.ws + WS_ADA);
  bf16_t* H = (bf16_t*)(p.ws + WS_H);
  for (int row = obid() * 8 + wid; row < NTOK; row += ogdim() * 8) {
    const float* src = (l == 0) ? (row < NPROMPT ? p.x_prompt + (size_t)row * DM : p.x_sample + (size_t)(row - NPROMPT) * DM) : p.out + (size_t)row * DM;
    f32x4 x[4];
    float ss = 0.f;
#pragma unroll
    for (int i = 0; i < 4; ++i) { x[i] = *(const f32x4*)(src + i * 256 + lane * 4); ss += x[i][0] * x[i][0] + x[i][1] * x[i][1] + x[i][2] * x[i][2] + x[i][3] * x[i][3]; }
#pragma unroll
    for (int m = 32; m >= 1; m >>= 1) ss += __shfl_xor(ss, m);
    const float rstd = rsqrtf(ss * (1.f / 1024.f) + EPS);
    if (l < 4) {
      const int cb = cond_of(row);
      const float* sh = ada + (l * 5 + cb) * 3072;
#pragma unroll
      for (int i = 0; i < 4; ++i) {
        const int idx = i * 256 + lane * 4;
        f32x4 g = *(const f32x4*)(p.norm_g + l * 1024 + idx);
        f32x4 s1 = *(const f32x4*)(sh + 1024 + idx);
        f32x4 s0 = *(const f32x4*)(sh + idx);
        float h0 = x[i][0] * rstd * g[0] * (1.f + s1[0]) + s0[0];
        float h1 = x[i][1] * rstd * g[1] * (1.f + s1[1]) + s0[1];
        float h2 = x[i][2] * rstd * g[2] * (1.f + s1[2]) + s0[2];
        float h3 = x[i][3] * rstd * g[3] * (1.f + s1[3]) + s0[3];
        uint2 o; o.x = pk2(h0, h1); o.y = pk2(h2, h3);
        *(uint2*)(H + (size_t)row * DM + idx) = o;
      }
    } else {
#pragma unroll
      for (int i = 0; i < 4; ++i) {
        const int idx = i * 256 + lane * 4;
        f32x4 g = *(const f32x4*)(p.final_norm_g + idx);
        f32x4 y = {x[i][0] * rstd * g[0], x[i][1] * rstd * g[1], x[i][2] * rstd * g[2], x[i][3] * rstd * g[3]};
        *(f32x4*)(p.out + (size_t)row * DM + idx) = y;
      }
    }
  }
}

__device__ __forceinline__ int lds_byte2(int r, int c) {
  int st = (r >> 4) * 2 + (c >> 5), ob = (r & 15) * 64 + (c & 31) * 2;
  return st * 1024 + (ob ^ (((ob >> 9) & 1) << 5));
}
__device__ __forceinline__ void stage_rc2(int b, int& R, int& C) {
  int st = b >> 10, sb = b & 1023, swz = sb ^ (((sb >> 9) & 1) << 5);
  R = (st >> 1) * 16 + swz / 64;
  C = (st & 1) * 32 + (swz % 64) / 2;
}
#define WAIT_V0() asm volatile("s_waitcnt vmcnt(0)" ::: "memory")

template <int EPI>
__device__ void gemm_phase(const Params& p, const bf16_t* __restrict__ A, int lda, const bf16_t* __restrict__ Bt, int nN, int l, int zs) {
  constexpr int BM = 256, BK = 64, TILE_B = BM * BK * 2, GL = 4, STAGE_B = 2 * TILE_B, NXCD = 8, WGM = 8, K = 1024;
  char* shm = g_smem;
  const int tid = otid(), wid = tid >> 6, lane = tid & 63, wr = wid >> 2, wc = wid & 3, fr = lane & 15, fq = lane >> 4;
  const int nM = NTOK / BM, nwg = nM * nN;
  int sR[GL], sC[GL];
#pragma unroll
  for (int i = 0; i < GL; ++i) stage_rc2(wid * 1024 + i * 8192 + lane * 16, sR[i], sC[i]);
  bf16_t* Zout = (bf16_t*)(p.ws + WS_Z);
  const float* ada = (const float*)(p.ws + WS_ADA);

  for (int it = 0;; ++it) {
    long L = (long)it * ogdim() + obid();
    if (L >= nwg) break;
    int wgid = (int)L;
    { int q = nwg / NXCD, r = nwg % NXCD, xcd = wgid % NXCD, off = wgid / NXCD; wgid = (xcd < r ? xcd * (q + 1) : r * (q + 1) + (xcd - r) * q) + off; }
    const int nig = WGM * nN, gid = wgid / nig, fm = gid * WGM, gsz = min(nM - fm, WGM);
    const int pm = fm + ((wgid % nig) % gsz), pn = (wgid % nig) / gsz, brow = pm * BM, bcol = pn * BM;
    const bf16_t* Ab = A + (size_t)brow * lda;
    const bf16_t* Bb = Bt + (size_t)bcol * K;
#define SA(b) (shm + (b) * STAGE_B)
#define SB(b) (shm + (b) * STAGE_B + TILE_B)
#define GLDS_STAGE(buf, kt) do { _Pragma("unroll") for (int i = 0; i < GL; ++i) { \
      __builtin_amdgcn_global_load_lds((const unsigned*)(Ab + (size_t)sR[i] * lda + (kt) * BK + sC[i]), (__attribute__((address_space(3))) unsigned*)(SA(buf) + wid * 1024 + i * 8192), 16, 0, 0); \
      __builtin_amdgcn_global_load_lds((const unsigned*)(Bb + (size_t)sR[i] * K + (kt) * BK + sC[i]), (__attribute__((address_space(3))) unsigned*)(SB(buf) + wid * 1024 + i * 8192), 16, 0, 0); } } while (0)
    f32x4 acc[8][4];
#pragma unroll
    for (int m = 0; m < 8; ++m)
#pragma unroll
      for (int n = 0; n < 4; ++n) acc[m][n] = (f32x4){0.f, 0.f, 0.f, 0.f};
    constexpr int nt = K / BK;
    GLDS_STAGE(0, 0); WAIT_V0(); __syncthreads();
    for (int t = 0; t < nt; ++t) {
      const int cur = t & 1;
      if (t + 1 < nt) GLDS_STAGE(cur ^ 1, t + 1);
#pragma unroll
      for (int ks = 0; ks < 2; ++ks) {
        bf16x8 At[8], Bf[4];
#pragma unroll
        for (int m = 0; m < 8; ++m) At[m] = *(const bf16x8*)(SA(cur) + lds_byte2(wr * 128 + m * 16 + fr, ks * 32 + fq * 8));
#pragma unroll
        for (int n = 0; n < 4; ++n) Bf[n] = *(const bf16x8*)(SB(cur) + lds_byte2(wc * 64 + n * 16 + fr, ks * 32 + fq * 8));
#pragma unroll
        for (int m = 0; m < 8; ++m)
#pragma unroll
          for (int n = 0; n < 4; ++n) acc[m][n] = MFMA16(Bf[n], At[m], acc[m][n]);
        __builtin_amdgcn_sched_barrier(0);
      }
      WAIT_V0(); __syncthreads();
    }
    if (EPI == 0) {
#pragma unroll
      for (int m = 0; m < 8; ++m) {
        const int row = brow + wr * 128 + m * 16 + fr;
#pragma unroll
        for (int n = 0; n < 4; ++n) {
          const int col = bcol + wc * 64 + n * 16 + fq * 4;
          if (col < zs) { uint2 o; o.x = pk2(acc[m][n][0], acc[m][n][1]); o.y = pk2(acc[m][n][2], acc[m][n][3]); *(uint2*)(Zout + (size_t)row * zs + col) = o; }
        }
      }
    } else {
      const int cb = cond_of(brow);
      const float* gate = ada + (l * 5 + cb) * 3072 + 2048;
      f32x4 gv[4];
#pragma unroll
      for (int n = 0; n < 4; ++n) gv[n] = *(const f32x4*)(gate + bcol + wc * 64 + n * 16 + fq * 4);
#pragma unroll
      for (int m = 0; m < 8; ++m) {
        const int row = brow + wr * 128 + m * 16 + fr;
        const float* xin = (l == 0) ? (row < NPROMPT ? p.x_prompt + (size_t)row * DM : p.x_sample + (size_t)(row - NPROMPT) * DM) : p.out + (size_t)row * DM;
#pragma unroll
        for (int n = 0; n < 4; ++n) {
          const int col = bcol + wc * 64 + n * 16 + fq * 4;
          f32x4 xv = *(const f32x4*)(xin + col);
          f32x4 o = {xv[0] + gv[n][0] * acc[m][n][0], xv[1] + gv[n][1] * acc[m][n][1], xv[2] + gv[n][2] * acc[m][n][2], xv[3] + gv[n][3] * acc[m][n][3]};
          *(f32x4*)(p.out + (size_t)row * DM + col) = o;
        }
      }
    }
  }
#undef SA
#undef SB
#undef GLDS_STAGE
}

__device__ __forceinline__ void gla_cum(const Params& p, int j, int h, const float* LR, float* SEG, int lane, int wid,
                                        float (&bf)[16], float (&bb)[16], float& totf, float& totb) {
  const int k = lane, seg = wid;
  float wf[16], wb[16];
  const float* wgf = p.w_gk + (size_t)((j * 2 + 0) * 16) * 256 + h * 64 + k;
  const float* wgb = p.w_gk + (size_t)((j * 2 + 1) * 16) * 256 + h * 64 + k;
#pragma unroll
  for (int r = 0; r < 16; ++r) { wf[r] = wgf[r * 256]; wb[r] = wgb[r * 256]; }
  const float biasf = p.b_gk[(j * 2 + 0) * 256 + h * 64 + k], biasb = p.b_gk[(j * 2 + 1) * 256 + h * 64 + k];
  float sf = 0.f, sb = 0.f;
#pragma unroll
  for (int i = 0; i < 16; ++i) {
    const f32x4* lr = (const f32x4*)(LR + (seg * 16 + i) * 32);
    float gf = biasf, gb = biasb;
#pragma unroll
    for (int r4 = 0; r4 < 4; ++r4) {
      f32x4 a = lr[r4], b = lr[4 + r4];
      gf += a[0] * wf[r4 * 4 + 0] + a[1] * wf[r4 * 4 + 1] + a[2] * wf[r4 * 4 + 2] + a[3] * wf[r4 * 4 + 3];
      gb += b[0] * wb[r4 * 4 + 0] + b[1] * wb[r4 * 4 + 1] + b[2] * wb[r4 * 4 + 2] + b[3] * wb[r4 * 4 + 3];
    }
    gf = logsig(gf) * (1.f / 16.f); gb = logsig(gb) * (1.f / 16.f);
    sf += gf; bf[i] = sf;
    bb[i] = gb; sb += gb;
  }
  SEG[(0 * 8 + seg) * 64 + k] = sf; SEG[(1 * 8 + seg) * 64 + k] = sb;
  __syncthreads();
  float offf = 0.f, offb = 0.f; totf = 0.f; totb = 0.f;
#pragma unroll
  for (int s = 0; s < 8; ++s) {
    float a = SEG[s * 64 + k], b = SEG[(8 + s) * 64 + k];
    totf += a; totb += b;
    if (s < seg) offf += a;
    if (s > seg) offb += b;
  }
#pragma unroll
  for (int i = 0; i < 16; ++i) bf[i] += offf;
  float run = offb;
#pragma unroll
  for (int i = 15; i >= 0; --i) { run += bb[i]; bb[i] = run; }
}

__device__ __forceinline__ void load_lr(const bf16_t* Z, int base, int C, bool colm, float* LR, int tid) {
  const int pos = tid >> 2, part = tid & 3;
  const int tok = tok_of(base, C * 128 + pos, colm);
  uint4 v = *(const uint4*)(Z + (size_t)tok * ZS_E + 3072 + part * 8);
  float* d = LR + pos * 32 + part * 8;
  d[0] = bflo(v.x); d[1] = bfhi(v.x); d[2] = bflo(v.y); d[3] = bfhi(v.y); d[4] = bflo(v.z); d[5] = bfhi(v.z); d[6] = bflo(v.w); d[7] = bfhi(v.w);
}
__device__ __forceinline__ void fill_T128(const bf16_t* Z, int zs, int base, int C, bool colm, int col0, char* DST, int ldb, int tid) {
#pragma unroll
  for (int ii = 0; ii < 4; ++ii) {
    const int id = tid + ii * 512, pos = id >> 4, vc = id & 15;
    const int tok = tok_of(base, C * 128 + pos, colm);
    uint4 v = *(const uint4*)(Z + (size_t)tok * zs + col0 + vc * 8);
#pragma unroll
    for (int e = 0; e < 8; ++e) *(bf16_t*)(DST + (vc * 8 + e) * ldb + pos * 2) = bfel(v, e);
  }
}

__device__ void m1_gla_item(const Params& p, int l, int item) {
  char* smem = g_smem;
  const int tid = otid(), lane = tid & 63, wid = tid >> 6, fr = lane & 15, fq = lane >> 4;
  const int cidx = item >> 2, h = item & 3, j = l >> 1;
  int base, T, C; chunk_info(cidx, base, T, C);
  const bool colm = (l >= 2) && (T == 4096);
  const bf16_t* Z = (const bf16_t*)(p.ws + WS_Z);
  float* LR = (float*)smem; float* SEG = (float*)(smem + 16384); char* KT = smem + 20480; char* VT = smem + 55296;
  float* ST = (float*)(p.ws + WS_H); float* DEC = (float*)(p.ws + WS_DEC);
  load_lr(Z, base, C, colm, LR, tid);
  fill_T128(Z, ZS_E, base, C, colm, 512 + h * 128, VT, 272, tid);
  __syncthreads();
  float bf[16], bb[16], totf, totb;
  gla_cum(p, j, h, LR, SEG, lane, wid, bf, bb, totf, totb);
  {
    const int k = lane, seg = wid;
#pragma unroll
    for (int i = 0; i < 16; ++i) {
      const int pos = seg * 16 + i;
      const int tok = tok_of(base, C * 128 + pos, colm);
      const float kv = bf2f(Z[(size_t)tok * ZS_E + 256 + h * 64 + k]);
      *(bf16_t*)(KT + k * 272 + pos * 2) = f2bf(kv * __expf(totf - bf[i]));
      *(bf16_t*)(KT + 17408 + k * 272 + pos * 2) = f2bf(kv * __expf(totb - bb[i]));
    }
    if (seg == 0) {
      DEC[((cidx * 4 + h) * 2 + 0) * 64 + k] = __expf(totf);
      DEC[((cidx * 4 + h) * 2 + 1) * 64 + k] = __expf(totb);
    }
  }
  __syncthreads();
  {
    const int dir = wid >> 2, kblk = wid & 3;
    f32x4 acc[8];
#pragma unroll
    for (int n = 0; n < 8; ++n) acc[n] = (f32x4){0.f, 0.f, 0.f, 0.f};
#pragma unroll
    for (int kb = 0; kb < 4; ++kb) {
      bf16x8 a = *(const bf16x8*)(KT + dir * 17408 + (kblk * 16 + fr) * 272 + (kb * 32 + fq * 8) * 2);
#pragma unroll
      for (int n = 0; n < 8; ++n) {
        bf16x8 b = *(const bf16x8*)(VT + (n * 16 + fr) * 272 + (kb * 32 + fq * 8) * 2);
        acc[n] = MFMA16(b, a, acc[n]);
      }
    }
    float* dst = ST + (size_t)((cidx * 4 + h) * 2 + dir) * 8192 + (kblk * 16 + fr) * 128 + fq * 4;
#pragma unroll
    for (int n = 0; n < 8; ++n) *(f32x4*)(dst + n * 16) = acc[n];
  }
  __syncthreads();
}

__device__ void sgu_item(const Params& p, int l, int item) {
  char* smem = g_smem;
  const int tid = otid(), lane = tid & 63, wid = tid >> 6, fr = lane & 15, fq = lane >> 4;
  const int cidx = item >> 2, hb = item & 3, j = l >> 1;
  int base, T, C; chunk_info(cidx, base, T, C);
  const bool colm = (l >= 2) && (T == 4096);
  bf16_t* Z = (bf16_t*)(p.ws + WS_Z);
  char* WS = smem; char* VNT = smem + 34816; float* RSTD = (float*)(smem + 69632);
  {
    const int pos = tid >> 2, part = tid & 3;
    const int tok = tok_of(base, C * 128 + pos, colm);
    const bf16_t* src = Z + (size_t)tok * ZS_E + 2048;
    float ss = 0.f;
#pragma unroll
    for (int i = 0; i < 16; ++i) {
      uint4 v = *(const uint4*)(src + (part + 4 * i) * 8);
      float a;
      a = bflo(v.x); ss += a * a; a = bfhi(v.x); ss += a * a; a = bflo(v.y); ss += a * a; a = bfhi(v.y); ss += a * a;
      a = bflo(v.z); ss += a * a; a = bfhi(v.z); ss += a * a; a = bflo(v.w); ss += a * a; a = bfhi(v.w); ss += a * a;
    }
    ss += __shfl_xor(ss, 1); ss += __shfl_xor(ss, 2);
    if (part == 0) RSTD[pos] = rsqrtf(ss * (1.f / 512.f) + EPS);
  }
  {
    const float* w = p.w_s + (size_t)(j * 4 + hb) * 16384;
#pragma unroll
    for (int ii = 0; ii < 8; ++ii) {
      const int id = tid + ii * 512, i = id >> 5, c4 = id & 31;
      f32x4 v = *(const f32x4*)(w + i * 128 + c4 * 4);
      uint2 o; o.x = pk2(v[0], v[1]); o.y = pk2(v[2], v[3]);
      *(uint2*)(WS + i * 272 + c4 * 8) = o;
    }
  }
  __syncthreads();
  {
#pragma unroll
    for (int ii = 0; ii < 4; ++ii) {
      const int id = tid + ii * 512, pos = id >> 4, vc = id & 15;
      const int tok = tok_of(base, C * 128 + pos, colm);
      uint4 v = *(const uint4*)(Z + (size_t)tok * ZS_E + 2048 + hb * 128 + vc * 8);
      const float rs = RSTD[pos];
      const float* g = p.sgu_norm_g + j * 512 + hb * 128 + vc * 8;
#pragma unroll
      for (int e = 0; e < 8; ++e) *(bf16_t*)(VNT + (vc * 8 + e) * 272 + pos * 2) = f2bf(bf2f(bfel(v, e)) * rs * g[e]);
    }
  }
  __syncthreads();
  {
    const int i0 = wid * 16;
    f32x4 acc[8];
#pragma unroll
    for (int n = 0; n < 8; ++n) acc[n] = (f32x4){0.f, 0.f, 0.f, 0.f};
#pragma unroll
    for (int kb = 0; kb < 4; ++kb) {
      bf16x8 a = *(const bf16x8*)(WS + (i0 + fr) * 272 + (kb * 32 + fq * 8) * 2);
#pragma unroll
      for (int n = 0; n < 8; ++n) {
        bf16x8 b = *(const bf16x8*)(VNT + (n * 16 + fr) * 272 + (kb * 32 + fq * 8) * 2);
        acc[n] = MFMA16(b, a, acc[n]);
      }
    }
    const int i = i0 + fr;
    const int tok = tok_of(base, C * 128 + i, colm);
    const float bs = p.b_s[(j * 4 + hb) * 128 + i];
    bf16_t* zr = Z + (size_t)tok * ZS_E;
#pragma unroll
    for (int n = 0; n < 8; ++n) {
      const int d = hb * 128 + n * 16 + fq * 4;
      uint2 u = *(const uint2*)(zr + 1024 + d), gb = *(const uint2*)(zr + 2560 + d);
      float o0 = bflo(u.x) * (acc[n][0] + bs) * silu_f(bflo(gb.x));
      float o1 = bfhi(u.x) * (acc[n][1] + bs) * silu_f(bfhi(gb.x));
      float o2 = bflo(u.y) * (acc[n][2] + bs) * silu_f(bflo(gb.y));
      float o3 = bfhi(u.y) * (acc[n][3] + bs) * silu_f(bfhi(gb.y));
      uint2 o; o.x = pk2(o0, o1); o.y = pk2(o2, o3);
      *(uint2*)(zr + 1024 + d) = o;
    }
  }
  __syncthreads();
}

template <int NCHK, int BATCH>
__device__ __forceinline__ void scan_chain(float* ST, const float* DEC, int cidx0, int h, int dir, int e, float S, float& Sout) {
  const int k = e >> 7;
#pragma unroll 1
  for (int s0 = 0; s0 < NCHK; s0 += BATCH) {
    float hv[BATCH], dv[BATCH];
#pragma unroll
    for (int i = 0; i < BATCH; ++i) {
      const int step = s0 + i, Cc = dir == 0 ? step : NCHK - 1 - step;
      const size_t idx = (size_t)(((cidx0 + Cc) * 4 + h) * 2 + dir);
      hv[i] = ST[idx * 8192 + e]; dv[i] = DEC[idx * 64 + k];
    }
#pragma unroll
    for (int i = 0; i < BATCH; ++i) {
      const int step = s0 + i, Cc = dir == 0 ? step : NCHK - 1 - step;
      const size_t idx = (size_t)(((cidx0 + Cc) * 4 + h) * 2 + dir);
      ST[idx * 8192 + e] = S;
      S = dv[i] * S + hv[i];
    }
  }
  Sout = S;
}
__device__ void m2_phase(const Params& p, int l) {
  const int tid = otid(), j = l >> 1;
  float* ST = (float*)(p.ws + WS_H); const float* DEC = (const float*)(p.ws + WS_DEC);
  for (int item = obid(); item < 512 + 4096; item += ogdim()) {
    float S, So;
    if (item < 512) {
      const int chain = item >> 4, slab = item & 15, b = chain >> 3, h = (chain >> 1) & 3, dir = chain & 1, e = slab * 512 + tid;
      S = p.state_gla[((size_t)((b * 2 + j) * 2 + dir) * 4 + h) * 8192 + e];
      scan_chain<32, 8>(ST, DEC, 64 + b * 32, h, dir, e, S, So);
    } else {
      const int it2 = item - 512, chain = it2 >> 4, slab = it2 & 15, b = chain >> 3, h = (chain >> 1) & 3, dir = chain & 1, e = slab * 512 + tid;
      S = 0.f;
      scan_chain<2, 2>(ST, DEC, b * 2, h, dir, e, S, So);
      p.out[(size_t)NTOK * DM + ((size_t)((b * 2 + j) * 2 + dir) * 4 + h) * 8192 + e] = So;
    }
  }
}

__device__ void m3_gla_item(const Params& p, int l, int item) {
  char* smem = g_smem;
  const int tid = otid(), lane = tid & 63, wid = tid >> 6, fr = lane & 15, fq = lane >> 4;
  const int cidx = item >> 2, h = item & 3, j = l >> 1;
  int base, T, C; chunk_info(cidx, base, T, C);
  const bool colm = (l >= 2) && (T == 4096);
  bf16_t* Z = (bf16_t*)(p.ws + WS_Z);
  char* AT = smem; char* VST = smem + 67584; char* KPf = smem + 67584; char* KPb = smem + 67584 + 18432;
  float* LR = (float*)(smem + 135168); float* SEG = (float*)(smem + 135168 + 16384);
  const float* ST = (const float*)(p.ws + WS_H);
  load_lr(Z, base, C, colm, LR, tid);
  __syncthreads();
  {
    float bf[16], bb[16], totf, totb;
    gla_cum(p, j, h, LR, SEG, lane, wid, bf, bb, totf, totb);
    const int k = lane, seg = wid;
#pragma unroll
    for (int i = 0; i < 16; ++i) {
      const int pos = seg * 16 + i;
      const int tok = tok_of(base, C * 128 + pos, colm);
      const float q = bf2f(Z[(size_t)tok * ZS_E + h * 64 + k]) * 0.125f;
      const float kk = bf2f(Z[(size_t)tok * ZS_E + 256 + h * 64 + k]);
      *(bf16_t*)(AT + pos * 528 + (128 + k) * 2) = f2bf(q * __expf(bf[i]));
      *(bf16_t*)(AT + pos * 528 + (192 + k) * 2) = f2bf(q * __expf(bb[i]));
      *(bf16_t*)(KPf + pos * 144 + k * 2) = f2bf(kk * __expf(-bf[i]));
      *(bf16_t*)(KPb + pos * 144 + k * 2) = f2bf(kk * __expf(-bb[i]));
    }
  }
  __syncthreads();
  const int i0 = wid * 16;
  {
    f32x4 pf[8], pb[8];
#pragma unroll
    for (int n = 0; n < 8; ++n) { pf[n] = (f32x4){0.f, 0.f, 0.f, 0.f}; pb[n] = (f32x4){0.f, 0.f, 0.f, 0.f}; }
#pragma unroll
    for (int kb = 0; kb < 2; ++kb) {
      bf16x8 aqf = *(const bf16x8*)(AT + (i0 + fr) * 528 + (128 + kb * 32 + fq * 8) * 2);
      bf16x8 aqb = *(const bf16x8*)(AT + (i0 + fr) * 528 + (192 + kb * 32 + fq * 8) * 2);
#pragma unroll
      for (int n = 0; n < 8; ++n) {
        bf16x8 bkf = *(const bf16x8*)(KPf + (n * 16 + fr) * 144 + (kb * 32 + fq * 8) * 2);
        bf16x8 bkb = *(const bf16x8*)(KPb + (n * 16 + fr) * 144 + (kb * 32 + fq * 8) * 2);
        pf[n] = MFMA16(bkf, aqf, pf[n]);
        pb[n] = MFMA16(bkb, aqb, pb[n]);
      }
    }
    const int i = i0 + fr;
#pragma unroll
    for (int n = 0; n < 8; ++n) {
      float a[4];
#pragma unroll
      for (int r = 0; r < 4; ++r) { const int jj = n * 16 + fq * 4 + r; a[r] = (jj <= i ? pf[n][r] : 0.f) + (jj >= i ? pb[n][r] : 0.f); }
      uint2 o; o.x = pk2(a[0], a[1]); o.y = pk2(a[2], a[3]);
      *(uint2*)(AT + i * 528 + (n * 16 + fq * 4) * 2) = o;
    }
  }
  __syncthreads();
  fill_T128(Z, ZS_E, base, C, colm, 512 + h * 128, VST, 528, tid);
#pragma unroll
  for (int dir = 0; dir < 2; ++dir) {
    const float* s = ST + (size_t)((cidx * 4 + h) * 2 + dir) * 8192;
#pragma unroll
    for (int ii = 0; ii < 4; ++ii) {
      const int id = tid + ii * 512, k = id >> 5, v4 = id & 31;
      f32x4 sv = *(const f32x4*)(s + k * 128 + v4 * 4);
#pragma unroll
      for (int e = 0; e < 4; ++e) *(bf16_t*)(VST + (v4 * 4 + e) * 528 + (128 + dir * 64 + k) * 2) = f2bf(sv[e]);
    }
  }
  __syncthreads();
  {
    f32x4 o[8];
#pragma unroll
    for (int n = 0; n < 8; ++n) o[n] = (f32x4){0.f, 0.f, 0.f, 0.f};
#pragma unroll
    for (int kb = 0; kb < 8; ++kb) {
      bf16x8 a = *(const bf16x8*)(AT + (i0 + fr) * 528 + (kb * 32 + fq * 8) * 2);
#pragma unroll
      for (int n = 0; n < 8; ++n) {
        bf16x8 b = *(const bf16x8*)(VST + (n * 16 + fr) * 528 + (kb * 32 + fq * 8) * 2);
        o[n] = MFMA16(b, a, o[n]);
      }
    }
    float ss = 0.f;
#pragma unroll
    for (int n = 0; n < 8; ++n) ss += o[n][0] * o[n][0] + o[n][1] * o[n][1] + o[n][2] * o[n][2] + o[n][3] * o[n][3];
    ss += __shfl_xor(ss, 16); ss += __shfl_xor(ss, 32);
    const float rstd = rsqrtf(ss * (1.f / 128.f) + EPS);
    const int tok = tok_of(base, C * 128 + i0 + fr, colm);
    bf16_t* zr = Z + (size_t)tok * ZS_E;
#pragma unroll
    for (int n = 0; n < 8; ++n) {
      const int v0 = n * 16 + fq * 4;
      uint2 ga = *(const uint2*)(zr + 1536 + h * 128 + v0);
      f32x4 g = *(const f32x4*)(p.gla_norm_g + j * 128 + v0);
      float r0 = o[n][0] * rstd * g[0] * silu_f(bflo(ga.x));
      float r1 = o[n][1] * rstd * g[1] * silu_f(bfhi(ga.x));
      float r2 = o[n][2] * rstd * g[2] * silu_f(bflo(ga.y));
      float r3 = o[n][3] * rstd * g[3] * silu_f(bfhi(ga.y));
      uint2 ov; ov.x = pk2(r0, r1); ov.y = pk2(r2, r3);
      *(uint2*)(zr + 512 + h * 128 + v0) = ov;
    }
  }
  __syncthreads();
}

__device__ void odd_item(const Params& p, int l, int item) {
  char* smem = g_smem;
  const int tid = otid(), lane = tid & 63, wid = tid >> 6, fr = lane & 15, fq = lane >> 4;
  const int cidx = item >> 2, g = item & 3, j = l >> 1;
  int base, T, C; chunk_info(cidx, base, T, C);
  const bool colm = (l >= 2) && (T == 4096);
  bf16_t* Z = (bf16_t*)(p.ws + WS_Z);
  char* XC = smem; char* PL = smem + 39168; char* WP = smem + 73984;
  const int p0 = C * 128;
  for (int id = tid; id < 144 * 16; id += 512) {
    const int r = id >> 4, cc = id & 15, pos = p0 - 8 + r;
    uint4 v = {0u, 0u, 0u, 0u};
    if (pos >= 0 && pos < T) v = *(const uint4*)(Z + (size_t)tok_of(base, pos, colm) * ZS_O + g * 128 + cc * 8);
    *(uint4*)(XC + r * 272 + cc * 16) = v;
  }
  {
    const float* w = p.w_pool + (size_t)(j * 4 + g) * 16384;
#pragma unroll
    for (int ii = 0; ii < 8; ++ii) {
      const int id = tid + ii * 512, c = id >> 5, d4 = id & 31;
      f32x4 v = *(const f32x4*)(w + c * 128 + d4 * 4);
#pragma unroll
      for (int e = 0; e < 4; ++e) *(bf16_t*)(WP + (d4 * 4 + e) * 272 + c * 2) = f2bf(v[e]);
    }
  }
  __syncthreads();
  {
    const int hw = 1 << g;
#pragma unroll
    for (int ii = 0; ii < 4; ++ii) {
      const int id = tid + ii * 512, t = id >> 4, cc = id & 15, pos = p0 + t;
      const int lo = max(pos - hw, 0), hi = min(pos + hw, T);
      float s[8];
#pragma unroll
      for (int e = 0; e < 8; ++e) s[e] = 0.f;
      for (int pp = lo; pp < hi; ++pp) {
        uint4 v = *(const uint4*)(XC + (pp - p0 + 8) * 272 + cc * 16);
        s[0] += bflo(v.x); s[1] += bfhi(v.x); s[2] += bflo(v.y); s[3] += bfhi(v.y); s[4] += bflo(v.z); s[5] += bfhi(v.z); s[6] += bflo(v.w); s[7] += bfhi(v.w);
      }
      const float inv = 1.f / (float)(hi - lo);
      uint4 cv = *(const uint4*)(XC + (t + 8) * 272 + cc * 16);
      uint4 o;
      o.x = pk2(s[0] * inv - bflo(cv.x), s[1] * inv - bfhi(cv.x));
      o.y = pk2(s[2] * inv - bflo(cv.y), s[3] * inv - bfhi(cv.y));
      o.z = pk2(s[4] * inv - bflo(cv.z), s[5] * inv - bfhi(cv.z));
      o.w = pk2(s[6] * inv - bflo(cv.w), s[7] * inv - bfhi(cv.w));
      *(uint4*)(PL + t * 272 + cc * 16) = o;
    }
  }
  __syncthreads();
  {
    const int i0 = wid * 16;
    f32x4 acc[8];
#pragma unroll
    for (int n = 0; n < 8; ++n) acc[n] = (f32x4){0.f, 0.f, 0.f, 0.f};
#pragma unroll
    for (int kb = 0; kb < 4; ++kb) {
      bf16x8 a = *(const bf16x8*)(PL + (i0 + fr) * 272 + (kb * 32 + fq * 8) * 2);
#pragma unroll
      for (int n = 0; n < 8; ++n) {
        bf16x8 b = *(const bf16x8*)(WP + (n * 16 + fr) * 272 + (kb * 32 + fq * 8) * 2);
        acc[n] = MFMA16(b, a, acc[n]);
      }
    }
    const int tok = tok_of(base, p0 + i0 + fr, colm);
    bf16_t* zr = Z + (size_t)tok * ZS_O;
#pragma unroll
    for (int n = 0; n < 8; ++n) {
      const int d = g * 128 + n * 16 + fq * 4;
      uint2 gc = *(const uint2*)(zr + 512 + d);
      f32x4 ps = *(const f32x4*)(p.pool_scale + j * 512 + d);
      float r0 = acc[n][0] * ps[0] * silu_f(bflo(gc.x));
      float r1 = acc[n][1] * ps[1] * silu_f(bfhi(gc.x));
      float r2 = acc[n][2] * ps[2] * silu_f(bflo(gc.y));
      float r3 = acc[n][3] * ps[3] * silu_f(bfhi(gc.y));
      uint2 o; o.x = pk2(r0, r1); o.y = pk2(r2, r3);
      *(uint2*)(zr + 512 + d) = o;
    }
  }
  {
#pragma unroll
    for (int ii = 0; ii < 4; ++ii) {
      const int id = tid + ii * 512, t = id >> 4, cc = id & 15, pos = p0 + t, ch = g * 128 + cc * 8;
      float u[3][8];
#pragma unroll
      for (int dd = 0; dd < 3; ++dd) {
        const int pp = pos - 1 + dd;
        if (pp >= 0 && pp < T) {
          const bf16_t* zr = Z + (size_t)tok_of(base, pp, colm) * ZS_O;
          uint4 xd = *(const uint4*)(zr + 1536 + ch), cd = *(const uint4*)(zr + 2048 + ch);
          u[dd][0] = bflo(xd.x) * bflo(cd.x); u[dd][1] = bfhi(xd.x) * bfhi(cd.x); u[dd][2] = bflo(xd.y) * bflo(cd.y); u[dd][3] = bfhi(xd.y) * bfhi(cd.y);
          u[dd][4] = bflo(xd.z) * bflo(cd.z); u[dd][5] = bfhi(xd.z) * bfhi(cd.z); u[dd][6] = bflo(xd.w) * bflo(cd.w); u[dd][7] = bfhi(xd.w) * bfhi(cd.w);
        } else {
#pragma unroll
          for (int e = 0; e < 8; ++e) u[dd][e] = 0.f;
        }
      }
      bf16_t* zr = Z + (size_t)tok_of(base, pos, colm) * ZS_O;
      uint4 bd = *(const uint4*)(zr + 1024 + ch), gd = *(const uint4*)(zr + 2560 + ch);
      const float* w0 = p.w_conv + (size_t)(j * 3 + 0) * 512 + ch;
      const float* w1 = p.w_conv + (size_t)(j * 3 + 1) * 512 + ch;
      const float* w2 = p.w_conv + (size_t)(j * 3 + 2) * 512 + ch;
      float o[8];
#pragma unroll
      for (int e = 0; e < 8; ++e) {
        const float y = u[0][e] * w0[e] + u[1][e] * w1[e] + u[2][e] * w2[e];
        o[e] = bf2f(bfel(bd, e)) * y * silu_f(bf2f(bfel(gd, e)));
      }
      uint4 ov; ov.x = pk2(o[0], o[1]); ov.y = pk2(o[2], o[3]); ov.z = pk2(o[4], o[5]); ov.w = pk2(o[6], o[7]);
      *(uint4*)(zr + 1024 + ch) = ov;
    }
  }
  __syncthreads();
}

__device__ __forceinline__ void run_phase(const Params& p, int ph, int l) {
  const bool even = (l & 1) == 0;
  const int j = l >> 1;
  switch (ph) {
    case 0: prep_phase(p); break;
    case 1: norm_phase(p, l); break;
    case 2:
      gemm_phase<0>(p, (const bf16_t*)(p.ws + WS_H), DM,
                    even ? (const bf16_t*)(p.ws + WS_WINE) + (size_t)j * NPAD_E * 1024 : (const bf16_t*)(p.ws + WS_WINO) + (size_t)j * 3072 * 1024,
                    even ? 13 : 12, l, even ? ZS_E : ZS_O);
      break;
    case 3:
      if (even) {
        for (int item = obid(); item < 1536; item += ogdim()) { if (item < 768) m1_gla_item(p, l, item); else sgu_item(p, l, item - 768); }
      } else {
        for (int item = obid(); item < 768; item += ogdim()) odd_item(p, l, item);
      }
      break;
    case 4: m2_phase(p, l); break;
    case 5: for (int item = obid(); item < 768; item += ogdim()) m3_gla_item(p, l, item); break;
    case 6:
      gemm_phase<1>(p, (const bf16_t*)(p.ws + WS_Z) + 512, even ? ZS_E : ZS_O, (const bf16_t*)(p.ws + WS_WOUT) + (size_t)l * 1024 * 1024, 4, l, 0);
      break;
  }
}

template <int PH> __global__ void __launch_bounds__(512, 2) k_phase(Params p, int l) { run_phase(p, PH, l); }

#if MEGA
__global__ void __launch_bounds__(512, 2) k_mega(Params p) {
  cg::grid_group grid = cg::this_grid();
  run_phase(p, 0, 0); grid.sync();
  run_phase(p, 1, 0); grid.sync();
#pragma unroll 1
  for (int l = 0; l < 4; ++l) {
    run_phase(p, 2, l); grid.sync();
    run_phase(p, 3, l); grid.sync();
    if ((l & 1) == 0) {
      run_phase(p, 4, l); grid.sync();
      run_phase(p, 5, l); grid.sync();
    }
    run_phase(p, 6, l); grid.sync();
    run_phase(p, 1, l + 1);
    if (l < 3) grid.sync();
  }
}

#endif

extern "C" void kernel_launch(void* const* d_in, const int* in_sizes, int n_in, void* d_out, int out_size, void* d_ws, size_t ws_size, hipStream_t stream) {
  Params p{};
  p.x_prompt = (const float*)d_in[0]; p.x_sample = (const float*)d_in[1]; p.c = (const float*)d_in[2]; p.state_gla = (const float*)d_in[3];
  p.c_ctx = (const float*)d_in[4]; p.w_ada = (const float*)d_in[5]; p.b_ada = (const float*)d_in[6]; p.norm_g = (const float*)d_in[7];
  p.w_in_even = (const float*)d_in[8]; p.w_in_odd = (const float*)d_in[9]; p.w_out = (const float*)d_in[10]; p.w_gk = (const float*)d_in[11];
  p.b_gk = (const float*)d_in[12]; p.gla_norm_g = (const float*)d_in[13]; p.sgu_norm_g = (const float*)d_in[14]; p.w_s = (const float*)d_in[15];
  p.b_s = (const float*)d_in[16]; p.w_pool = (const float*)d_in[17]; p.pool_scale = (const float*)d_in[18]; p.w_conv = (const float*)d_in[19];
  p.final_norm_g = (const float*)d_in[20];
  p.out = (float*)d_out; p.ws = (char*)d_ws;
#if MEGA
  static int grid_blocks = 0;
  if (!grid_blocks) {
    int dev = 0, cus = 0, per_cu = 0;
    hipGetDevice(&dev);
    hipDeviceGetAttribute(&cus, hipDeviceAttributeMultiprocessorCount, dev);
    hipOccupancyMaxActiveBlocksPerMultiprocessor(&per_cu, k_mega, 512, 0);
    if (per_cu < 1) per_cu = 1;
    grid_blocks = cus;
  }
  void* args[] = {&p};
  hipError_t e = hipLaunchCooperativeKernel((void*)k_mega, dim3(grid_blocks), dim3(512), args, 0, stream);
  if (e != hipSuccess) fprintf(stderr, "cooperative launch failed: %s (grid %d)\n", hipGetErrorString(e), grid_blocks);
#else
  const int G = 256;
  k_phase<0><<<G, 512, 0, stream>>>(p, 0);
  k_phase<1><<<G, 512, 0, stream>>>(p, 0);
  for (int l = 0; l < 4; ++l) {
    k_phase<2><<<G, 512, 0, stream>>>(p, l);
    k_phase<3><<<G, 512, 0, stream>>>(p, l);
    if ((l & 1) == 0) { k_phase<4><<<G, 512, 0, stream>>>(p, l); k_phase<5><<<G, 512, 0, stream>>>(p, l); }
    k_phase<6><<<G, 512, 0, stream>>>(p, l);
    k_phase<1><<<G, 512, 0, stream>>>(p, l + 1);
  }
#endif
}
```

```cpp
#include <hip/hip_runtime.h>
#include <hip/hip_cooperative_groups.h>
#include <stdint.h>
#include <stdio.h>
namespace cg = cooperative_groups;

#ifndef MEGA
#define MEGA 1
#endif

typedef unsigned short bf16_t;
typedef short bf16x8 __attribute__((ext_vector_type(8)));
typedef float f32x4 __attribute__((ext_vector_type(4)));

constexpr int NTOK = 24576;
constexpr int NPROMPT = 8192;
constexpr int DM = 1024;
constexpr int ZS_E = 3104, ZS_O = 3072, NPAD_E = 3328;
constexpr float EPS = 1e-6f;
constexpr int LDS_BYTES = 155648 + 16;
constexpr int NCH = 192;

constexpr size_t WS_ADA = 0;
constexpr size_t WS_DEC = 262144;
constexpr size_t WS_BAR = 720896;
constexpr size_t WS_WINE = 1048576;
constexpr size_t WS_WINO = WS_WINE + 2ull * 3328 * 1024 * 2;
constexpr size_t WS_WOUT = WS_WINO + 2ull * 3072 * 1024 * 2;
constexpr size_t WS_Z = 36700160;
constexpr size_t WS_H = 190840832;

struct Params {
  const float *x_prompt, *x_sample, *c, *state_gla, *c_ctx, *w_ada, *b_ada, *norm_g, *w_in_even, *w_in_odd, *w_out, *w_gk, *b_gk,
      *gla_norm_g, *sgu_norm_g, *w_s, *b_s, *w_pool, *pool_scale, *w_conv, *final_norm_g;
  float* out;
  char* ws;
};

__shared__ __attribute__((aligned(1024))) char g_smem[LDS_BYTES];

__device__ __forceinline__ float bf2f(bf16_t b) { return __uint_as_float(((uint32_t)b) << 16); }
__device__ __forceinline__ float bflo(uint32_t w) { return __uint_as_float(w << 16); }
__device__ __forceinline__ float bfhi(uint32_t w) { return __uint_as_float(w & 0xffff0000u); }
__device__ __forceinline__ bf16_t f2bf(float f) { uint32_t u = __float_as_uint(f); u += 0x7fffu + ((u >> 16) & 1u); return (bf16_t)(u >> 16); }
__device__ __forceinline__ uint32_t pk2(float lo, float hi) { uint32_t r; asm("v_cvt_pk_bf16_f32 %0, %1, %2" : "=v"(r) : "v"(lo), "v"(hi)); return r; }
__device__ __forceinline__ float silu_f(float x) { return x / (1.f + __expf(-x)); }
__device__ __forceinline__ float logsig(float x) { return fminf(x, 0.f) - __logf(1.f + __expf(-fabsf(x))); }
__device__ __forceinline__ bf16_t bfel(const uint4& v, int e) { uint32_t w = (e >> 1) == 0 ? v.x : (e >> 1) == 1 ? v.y : (e >> 1) == 2 ? v.z : v.w; return (bf16_t)((e & 1) ? (w >> 16) : (w & 0xffffu)); }

__device__ __forceinline__ void chunk_info(int cidx, int& base, int& T, int& C) {
  if (cidx < 64) { C = cidx & 1; T = 256; base = (cidx >> 1) * 256; }
  else { int cs = cidx - 64; C = cs & 31; T = 4096; base = NPROMPT + (cs >> 5) * 4096; }
}
__device__ __forceinline__ int tok_of(int base, int p, bool colm) { return base + (colm ? ((p & 63) * 64 + (p >> 6)) : p); }
__device__ __forceinline__ int cond_of(int row) { return row < NPROMPT ? 0 : 1 + ((row - NPROMPT) >> 12); }

__device__ __forceinline__ int otid() { int t = threadIdx.x; asm volatile("" : "+v"(t)); return t; }
__device__ __forceinline__ int obid() { int b = blockIdx.x; asm volatile("" : "+s"(b)); return b; }
__device__ __forceinline__ int ogdim() { int b = gridDim.x; asm volatile("" : "+s"(b)); return b; }

#define MFMA16(a, b, c) __builtin_amdgcn_mfma_f32_16x16x32_bf16((a), (b), (c), 0, 0, 0)

__device__ __forceinline__ int src_col_even(int n) {
  if (n < 1024) return n;
  if (n < 1536) return 1568 + (n - 1024);
  if (n < 2048) return 1024 + (n - 1536);
  if (n < 2560) return 2080 + (n - 2048);
  if (n < 3072) return 2592 + (n - 2560);
  if (n < 3104) return 1536 + (n - 3072);
  return -1;
}
__device__ __forceinline__ int src_col_odd(int n) {
  if (n >= 1024 && n < 1536) return n + 512;
  if (n >= 1536 && n < 2048) return n - 512;
  return n;
}

__device__ void prep_phase(const Params& p) {
  const int tid = otid();
  char* smem = g_smem;
  constexpr int N_ADA = 192, N_TR = 4224;
  for (int item = obid(); item < N_ADA + N_TR; item += ogdim()) {
    if (item < N_ADA) {
      const int l = item / 48, n0 = (item % 48) * 64;
      float* SC = (float*)smem;
      float* RED = (float*)(smem + 20480);
      for (int i = tid; i < 5120; i += 512) {
        int cb = i >> 10, k = i & 1023;
        float v = cb == 0 ? p.c_ctx[k] : p.c[(cb - 1) * 1024 + k];
        SC[i] = silu_f(v);
      }
      __syncthreads();
      const int col = tid & 63, ks = tid >> 6;
      float a0 = 0, a1 = 0, a2 = 0, a3 = 0, a4 = 0;
      const float* w = p.w_ada + (size_t)l * 1024 * 3072 + n0 + col;
#pragma unroll 8
      for (int kk = 0; kk < 128; ++kk) {
        int k = ks * 128 + kk;
        float wv = w[(size_t)k * 3072];
        a0 += SC[k] * wv; a1 += SC[1024 + k] * wv; a2 += SC[2048 + k] * wv; a3 += SC[3072 + k] * wv; a4 += SC[4096 + k] * wv;
      }
      RED[(ks * 5 + 0) * 64 + col] = a0; RED[(ks * 5 + 1) * 64 + col] = a1; RED[(ks * 5 + 2) * 64 + col] = a2;
      RED[(ks * 5 + 3) * 64 + col] = a3; RED[(ks * 5 + 4) * 64 + col] = a4;
      __syncthreads();
      if (tid < 320) {
        int cb = tid >> 6, cc = tid & 63;
        float s = p.b_ada[l * 3072 + n0 + cc];
        for (int q = 0; q < 8; ++q) s += RED[(q * 5 + cb) * 64 + cc];
        ((float*)(p.ws + WS_ADA))[(l * 5 + cb) * 3072 + n0 + cc] = s;
      }
      __syncthreads();
    } else {
      int t = item - N_ADA;
      const float* src; bf16_t* dst; int nsrc, kind, nt, kt;
      if (t < 1664) { int j = t / 832, r = t % 832; nt = r >> 4; kt = r & 15; src = p.w_in_even + (size_t)j * 1024 * 3104; nsrc = 3104; dst = (bf16_t*)(p.ws + WS_WINE) + (size_t)j * NPAD_E * 1024; kind = 0; }
      else if (t < 3200) { int tt = t - 1664; int j = tt / 768, r = tt % 768; nt = r >> 4; kt = r & 15; src = p.w_in_odd + (size_t)j * 1024 * 3072; nsrc = 3072; dst = (bf16_t*)(p.ws + WS_WINO) + (size_t)j * 3072 * 1024; kind = 1; }
      else { int tt = t - 3200; int l = tt >> 8, r = tt & 255; nt = r >> 4; kt = r & 15; src = p.w_out + (size_t)l * 1024 * 1024; nsrc = 1024; dst = (bf16_t*)(p.ws + WS_WOUT) + (size_t)l * 1024 * 1024; kind = 2; }
      float* T = (float*)smem;
      const int n0 = nt * 64, k0 = kt * 64;
      {
        const int c4 = tid & 15, kr = tid >> 4;
        const int nn = n0 + c4 * 4;
        const int sc = kind == 0 ? src_col_even(nn) : kind == 1 ? src_col_odd(nn) : nn;
#pragma unroll
        for (int ps = 0; ps < 2; ++ps) {
          int k = kr + ps * 32;
          f32x4 v = {0.f, 0.f, 0.f, 0.f};
          if (sc >= 0) v = *(const f32x4*)(src + (size_t)(k0 + k) * nsrc + sc);
          T[k * 65 + c4 * 4 + 0] = v[0]; T[k * 65 + c4 * 4 + 1] = v[1]; T[k * 65 + c4 * 4 + 2] = v[2]; T[k * 65 + c4 * 4 + 3] = v[3];
        }
      }
      __syncthreads();
      {
        const int n = tid >> 3, kc = tid & 7;
        uint4 o;
        o.x = pk2(T[(kc * 8 + 0) * 65 + n], T[(kc * 8 + 1) * 65 + n]);
        o.y = pk2(T[(kc * 8 + 2) * 65 + n], T[(kc * 8 + 3) * 65 + n]);
        o.z = pk2(T[(kc * 8 + 4) * 65 + n], T[(kc * 8 + 5) * 65 + n]);
        o.w = pk2(T[(kc * 8 + 6) * 65 + n], T[(kc * 8 + 7) * 65 + n]);
        *(uint4*)(dst + (size_t)(n0 + n) * 1024 + k0 + kc * 8) = o;
      }
      __syncthreads();
    }
  }
}

__device__ void norm_phase(const Params& p, int l) {
  const int tid = otid(), lane = tid & 63, wid = tid >> 6;
  const float* ada = (const float*)(p.ws + WS_ADA);
  bf16_t* H = (bf16_t*)(p.ws + WS_H);
  for (int row = obid() * 8 + wid; row < NTOK; row += ogdim() * 8) {
    const float* src = (l == 0) ? (row < NPROMPT ? p.x_prompt + (size_t)row * DM : p.x_sample + (size_t)(row - NPROMPT) * DM) : p.out + (size_t)row * DM;
    f32x4 x[4];
    float ss = 0.f;
#pragma unroll
    for (int i = 0; i < 4; ++i) { x[i] = *(const f32x4*)(src + i * 256 + lane * 4); ss += x[i][0] * x[i][0] + x[i][1] * x[i][1] + x[i][2] * x[i][2] + x[i][3] * x[i][3]; }
#pragma unroll
    for (int m = 32; m >= 1; m >>= 1) ss += __shfl_xor(ss, m);
    const float rstd = rsqrtf(ss * (1.f / 1024.f) + EPS);
    if (l < 4) {
      const int cb = cond_of(row);
      const float* sh = ada + (l * 5 + cb) * 3072;
#pragma unroll
      for (int i = 0; i < 4; ++i) {
        const int idx = i * 256 + lane * 4;
        f32x4 g = *(const f32x4*)(p.norm_g + l * 1024 + idx);
        f32x4 s1 = *(const f32x4*)(sh + 1024 + idx);
        f32x4 s0 = *(const f32x4*)(sh + idx);
        float h0 = x[i][0] * rstd * g[0] * (1.f + s1[0]) + s0[0];
        float h1 = x[i][1] * rstd * g[1] * (1.f + s1[1]) + s0[1];
        float h2 = x[i][2] * rstd * g[2] * (1.f + s1[2]) + s0[2];
        float h3 = x[i][3] * rstd * g[3] * (1.f + s1[3]) + s0[3];
        uint2 o; o.x = pk2(h0, h1); o.y = pk2(h2, h3);
        *(uint2*)(H + (size_t)row * DM + idx) = o;
      }
    } else {
#pragma unroll
      for (int i = 0; i < 4; ++i) {
        const int idx = i * 256 + lane * 4;
        f32x4 g = *(const f32x4*)(p.final_norm_g + idx);
        f32x4 y = {x[i][0] * rstd * g[0], x[i][1] * rstd * g[1], x[i][2] * rstd * g[2], x[i][3] * rstd * g[3]};
        *(f32x4*)(p.out + (size_t)row * DM + idx) = y;
      }
    }
  }
}

__device__ __forceinline__ int lds_byte2(int r, int c) {
  int st = (r >> 4) * 2 + (c >> 5), ob = (r & 15) * 64 + (c & 31) * 2;
  return st * 1024 + (ob ^ (((ob >> 9) & 1) << 5));
}
__device__ __forceinline__ void stage_rc2(int b, int& R, int& C) {
  int st = b >> 10, sb = b & 1023, swz = sb ^ (((sb >> 9) & 1) << 5);
  R = (st >> 1) * 16 + swz / 64;
  C = (st & 1) * 32 + (swz % 64) / 2;
}
#define WAIT_V0() asm volatile("s_waitcnt vmcnt(0)" ::: "memory")

template <int EPI>
__device__ void gemm_phase(const Params& p, const bf16_t* __restrict__ A, int lda, const bf16_t* __restrict__ Bt, int nN, int l, int zs) {
  constexpr int BM = 256, BK = 64, TILE_B = BM * BK * 2, GL = 4, STAGE_B = 2 * TILE_B, NXCD = 8, WGM = 8, K = 1024;
  char* shm = g_smem;
  const int tid = otid(), wid = tid >> 6, lane = tid & 63, wr = wid >> 2, wc = wid & 3, fr = lane & 15, fq = lane >> 4;
  const int nM = NTOK / BM, nwg = nM * nN;
  int sR[GL], sC[GL];
#pragma unroll
  for (int i = 0; i < GL; ++i) stage_rc2(wid * 1024 + i * 8192 + lane * 16, sR[i], sC[i]);
  bf16_t* Zout = (bf16_t*)(p.ws + WS_Z);
  const float* ada = (const float*)(p.ws + WS_ADA);

  for (int it = 0;; ++it) {
    long L = (long)it * ogdim() + obid();
    if (L >= nwg) break;
    int wgid = (int)L;
    { int q = nwg / NXCD, r = nwg % NXCD, xcd = wgid % NXCD, off = wgid / NXCD; wgid = (xcd < r ? xcd * (q + 1) : r * (q + 1) + (xcd - r) * q) + off; }
    const int nig = WGM * nN, gid = wgid / nig, fm = gid * WGM, gsz = min(nM - fm, WGM);
    const int pm = fm + ((wgid % nig) % gsz), pn = (wgid % nig) / gsz, brow = pm * BM, bcol = pn * BM;
    const bf16_t* Ab = A + (size_t)brow * lda;
    const bf16_t* Bb = Bt + (size_t)bcol * K;
#define SA(b) (shm + (b) * STAGE_B)
#define SB(b) (shm + (b) * STAGE_B + TILE_B)
#define GLDS_STAGE(buf, kt) do { _Pragma("unroll") for (int i = 0; i < GL; ++i) { \
      __builtin_amdgcn_global_load_lds((const unsigned*)(Ab + (size_t)sR[i] * lda + (kt) * BK + sC[i]), (__attribute__((address_space(3))) unsigned*)(SA(buf) + wid * 1024 + i * 8192), 16, 0, 0); \
      __builtin_amdgcn_global_load_lds((const unsigned*)(Bb + (size_t)sR[i] * K + (kt) * BK + sC[i]), (__attribute__((address_space(3))) unsigned*)(SB(buf) + wid * 1024 + i * 8192), 16, 0, 0); } } while (0)
    f32x4 acc[8][4];
#pragma unroll
    for (int m = 0; m < 8; ++m)
#pragma unroll
      for (int n = 0; n < 4; ++n) acc[m][n] = (f32x4){0.f, 0.f, 0.f, 0.f};
    constexpr int nt = K / BK;
    GLDS_STAGE(0, 0); WAIT_V0(); __syncthreads();
    for (int t = 0; t < nt; ++t) {
      const int cur = t & 1;
      if (t + 1 < nt) GLDS_STAGE(cur ^ 1, t + 1);
#pragma unroll
      for (int ks = 0; ks < 2; ++ks) {
        bf16x8 At[8], Bf[4];
#pragma unroll
        for (int m = 0; m < 8; ++m) At[m] = *(const bf16x8*)(SA(cur) + lds_byte2(wr * 128 + m * 16 + fr, ks * 32 + fq * 8));
#pragma unroll
        for (int n = 0; n < 4; ++n) Bf[n] = *(const bf16x8*)(SB(cur) + lds_byte2(wc * 64 + n * 16 + fr, ks * 32 + fq * 8));
#pragma unroll
        for (int m = 0; m < 8; ++m)
#pragma unroll
          for (int n = 0; n < 4; ++n) acc[m][n] = MFMA16(Bf[n], At[m], acc[m][n]);
        __builtin_amdgcn_sched_barrier(0);
      }
      WAIT_V0(); __syncthreads();
    }
    if (EPI == 0) {
#pragma unroll
      for (int m = 0; m < 8; ++m) {
        const int row = brow + wr * 128 + m * 16 + fr;
#pragma unroll
        for (int n = 0; n < 4; ++n) {
          const int col = bcol + wc * 64 + n * 16 + fq * 4;
          if (col < zs) { uint2 o; o.x = pk2(acc[m][n][0], acc[m][n][1]); o.y = pk2(acc[m][n][2], acc[m][n][3]); *(uint2*)(Zout + (size_t)row * zs + col) = o; }
        }
      }
    } else {
      const int cb = cond_of(brow);
      const float* gate = ada + (l * 5 + cb) * 3072 + 2048;
      f32x4 gv[4];
#pragma unroll
      for (int n = 0; n < 4; ++n) gv[n] = *(const f32x4*)(gate + bcol + wc * 64 + n * 16 + fq * 4);
#pragma unroll
      for (int m = 0; m < 8; ++m) {
        const int row = brow + wr * 128 + m * 16 + fr;
        const float* xin = (l == 0) ? (row < NPROMPT ? p.x_prompt + (size_t)row * DM : p.x_sample + (size_t)(row - NPROMPT) * DM) : p.out + (size_t)row * DM;
#pragma unroll
        for (int n = 0; n < 4; ++n) {
          const int col = bcol + wc * 64 + n * 16 + fq * 4;
          f32x4 xv = *(const f32x4*)(xin + col);
          f32x4 o = {xv[0] + gv[n][0] * acc[m][n][0], xv[1] + gv[n][1] * acc[m][n][1], xv[2] + gv[n][2] * acc[m][n][2], xv[3] + gv[n][3] * acc[m][n][3]};
          *(f32x4*)(p.out + (size_t)row * DM + col) = o;
        }
      }
    }
  }
#undef SA
#undef SB
#undef GLDS_STAGE
}

__device__ __forceinline__ void gla_cum(const Params& p, int j, int h, const float* LR, float* SEG, int lane, int wid,
                                        float (&bf)[16], float (&bb)[16], float& totf, float& totb) {
  const int k = lane, seg = wid;
  float wf[16], wb[16];
  const float* wgf = p.w_gk + (size_t)((j * 2 + 0) * 16) * 256 + h * 64 + k;
  const float* wgb = p.w_gk + (size_t)((j * 2 + 1) * 16) * 256 + h * 64 + k;
#pragma unroll
  for (int r = 0; r < 16; ++r) { wf[r] = wgf[r * 256]; wb[r] = wgb[r * 256]; }
  const float biasf = p.b_gk[(j * 2 + 0) * 256 + h * 64 + k], biasb = p.b_gk[(j * 2 + 1) * 256 + h * 64 + k];
  float sf = 0.f, sb = 0.f;
#pragma unroll
  for (int i = 0; i < 16; ++i) {
    const f32x4* lr = (const f32x4*)(LR + (seg * 16 + i) * 32);
    float gf = biasf, gb = biasb;
#pragma unroll
    for (int r4 = 0; r4 < 4; ++r4) {
      f32x4 a = lr[r4], b = lr[4 + r4];
      gf += a[0] * wf[r4 * 4 + 0] + a[1] * wf[r4 * 4 + 1] + a[2] * wf[r4 * 4 + 2] + a[3] * wf[r4 * 4 + 3];
      gb += b[0] * wb[r4 * 4 + 0] + b[1] * wb[r4 * 4 + 1] + b[2] * wb[r4 * 4 + 2] + b[3] * wb[r4 * 4 + 3];
    }
    gf = logsig(gf) * (1.f / 16.f); gb = logsig(gb) * (1.f / 16.f);
    sf += gf; bf[i] = sf;
    bb[i] = gb; sb += gb;
  }
  SEG[(0 * 8 + seg) * 64 + k] = sf; SEG[(1 * 8 + seg) * 64 + k] = sb;
  __syncthreads();
  float offf = 0.f, offb = 0.f; totf = 0.f; totb = 0.f;
#pragma unroll
  for (int s = 0; s < 8; ++s) {
    float a = SEG[s * 64 + k], b = SEG[(8 + s) * 64 + k];
    totf += a; totb += b;
    if (s < seg) offf += a;
    if (s > seg) offb += b;
  }
#pragma unroll
  for (int i = 0; i < 16; ++i) bf[i] += offf;
  float run = offb;
#pragma unroll
  for (int i = 15; i >= 0; --i) { run += bb[i]; bb[i] = run; }
}

__device__ __forceinline__ void load_lr(const bf16_t* Z, int base, int C, bool colm, float* LR, int tid) {
  const int pos = tid >> 2, part = tid & 3;
  const int tok = tok_of(base, C * 128 + pos, colm);
  uint4 v = *(const uint4*)(Z + (size_t)tok * ZS_E + 3072 + part * 8);
  float* d = LR + pos * 32 + part * 8;
  d[0] = bflo(v.x); d[1] = bfhi(v.x); d[2] = bflo(v.y); d[3] = bfhi(v.y); d[4] = bflo(v.z); d[5] = bfhi(v.z); d[6] = bflo(v.w); d[7] = bfhi(v.w);
}
__device__ __forceinline__ void fill_T128(const bf16_t* Z, int zs, int base, int C, bool colm, int col0, char* DST, int ldb, int tid) {
#pragma unroll
  for (int ii = 0; ii < 4; ++ii) {
    const int id = tid + ii * 512, pos = id >> 4, vc = id & 15;
    const int tok = tok_of(base, C * 128 + pos, colm);
    uint4 v = *(const uint4*)(Z + (size_t)tok * zs + col0 + vc * 8);
#pragma unroll
    for (int e = 0; e < 8; ++e) *(bf16_t*)(DST + (vc * 8 + e) * ldb + pos * 2) = bfel(v, e);
  }
}

__device__ void m1_gla_item(const Params& p, int l, int item) {
  char* smem = g_smem;
  const int tid = otid(), lane = tid & 63, wid = tid >> 6, fr = lane & 15, fq = lane >> 4;
  const int cidx = item >> 2, h = item & 3, j = l >> 1;
  int base, T, C; chunk_info(cidx, base, T, C);
  const bool colm = (l >= 2) && (T == 4096);
  const bf16_t* Z = (const bf16_t*)(p.ws + WS_Z);
  float* LR = (float*)smem; float* SEG = (float*)(smem + 16384); char* KT = smem + 20480; char* VT = smem + 55296;
  float* ST = (float*)(p.ws + WS_H); float* DEC = (float*)(p.ws + WS_DEC);
  load_lr(Z, base, C, colm, LR, tid);
  fill_T128(Z, ZS_E, base, C, colm, 512 + h * 128, VT, 272, tid);
  __syncthreads();
  float bf[16], bb[16], totf, totb;
  gla_cum(p, j, h, LR, SEG, lane, wid, bf, bb, totf, totb);
  {
    const int k = lane, seg = wid;
#pragma unroll
    for (int i = 0; i < 16; ++i) {
      const int pos = seg * 16 + i;
      const int tok = tok_of(base, C * 128 + pos, colm);
      const float kv = bf2f(Z[(size_t)tok * ZS_E + 256 + h * 64 + k]);
      *(bf16_t*)(KT + k * 272 + pos * 2) = f2bf(kv * __expf(totf - bf[i]));
      *(bf16_t*)(KT + 17408 + k * 272 + pos * 2) = f2bf(kv * __expf(totb - bb[i]));
    }
    if (seg == 0) {
      DEC[((cidx * 4 + h) * 2 + 0) * 64 + k] = __expf(totf);
      DEC[((cidx * 4 + h) * 2 + 1) * 64 + k] = __expf(totb);
    }
  }
  __syncthreads();
  {
    const int dir = wid >> 2, kblk = wid & 3;
    f32x4 acc[8];
#pragma unroll
    for (int n = 0; n < 8; ++n) acc[n] = (f32x4){0.f, 0.f, 0.f, 0.f};
#pragma unroll
    for (int kb = 0; kb < 4; ++kb) {
      bf16x8 a = *(const bf16x8*)(KT + dir * 17408 + (kblk * 16 + fr) * 272 + (kb * 32 + fq * 8) * 2);
#pragma unroll
      for (int n = 0; n < 8; ++n) {
        bf16x8 b = *(const bf16x8*)(VT + (n * 16 + fr) * 272 + (kb * 32 + fq * 8) * 2);
        acc[n] = MFMA16(b, a, acc[n]);
      }
    }
    float* dst = ST + (size_t)((cidx * 4 + h) * 2 + dir) * 8192 + (kblk * 16 + fr) * 128 + fq * 4;
#pragma unroll
    for (int n = 0; n < 8; ++n) *(f32x4*)(dst + n * 16) = acc[n];
  }
  __syncthreads();
}

__device__ void sgu_item(const Params& p, int l, int item) {
  char* smem = g_smem;
  const int tid = otid(), lane = tid & 63, wid = tid >> 6, fr = lane & 15, fq = lane >> 4;
  const int cidx = item >> 2, hb = item & 3, j = l >> 1;
  int base, T, C; chunk_info(cidx, base, T, C);
  const bool colm = (l >= 2) && (T == 4096);
  bf16_t* Z = (bf16_t*)(p.ws + WS_Z);
  char* WS = smem; char* VNT = smem + 34816; float* RSTD = (float*)(smem + 69632);
  {
    const int pos = tid >> 2, part = tid & 3;
    const int tok = tok_of(base, C * 128 + pos, colm);
    const bf16_t* src = Z + (size_t)tok * ZS_E + 2048;
    float ss = 0.f;
#pragma unroll
    for (int i = 0; i < 16; ++i) {
      uint4 v = *(const uint4*)(src + (part + 4 * i) * 8);
      float a;
      a = bflo(v.x); ss += a * a; a = bfhi(v.x); ss += a * a; a = bflo(v.y); ss += a * a; a = bfhi(v.y); ss += a * a;
      a = bflo(v.z); ss += a * a; a = bfhi(v.z); ss += a * a; a = bflo(v.w); ss += a * a; a = bfhi(v.w); ss += a * a;
    }
    ss += __shfl_xor(ss, 1); ss += __shfl_xor(ss, 2);
    if (part == 0) RSTD[pos] = rsqrtf(ss * (1.f / 512.f) + EPS);
  }
  {
    const float* w = p.w_s + (size_t)(j * 4 + hb) * 16384;
#pragma unroll
    for (int ii = 0; ii < 8; ++ii) {
      const int id = tid + ii * 512, i = id >> 5, c4 = id & 31;
      f32x4 v = *(const f32x4*)(w + i * 128 + c4 * 4);
      uint2 o; o.x = pk2(v[0], v[1]); o.y = pk2(v[2], v[3]);
      *(uint2*)(WS + i * 272 + c4 * 8) = o;
    }
  }
  __syncthreads();
  {
#pragma unroll
    for (int ii = 0; ii < 4; ++ii) {
      const int id = tid + ii * 512, pos = id >> 4, vc = id & 15;
      const int tok = tok_of(base, C * 128 + pos, colm);
      uint4 v = *(const uint4*)(Z + (size_t)tok * ZS_E + 2048 + hb * 128 + vc * 8);
      const float rs = RSTD[pos];
      const float* g = p.sgu_norm_g + j * 512 + hb * 128 + vc * 8;
#pragma unroll
      for (int e = 0; e < 8; ++e) *(bf16_t*)(VNT + (vc * 8 + e) * 272 + pos * 2) = f2bf(bf2f(bfel(v, e)) * rs * g[e]);
    }
  }
  __syncthreads();
  {
    const int i0 = wid * 16;
    f32x4 acc[8];
#pragma unroll
    for (int n = 0; n < 8; ++n) acc[n] = (f32x4){0.f, 0.f, 0.f, 0.f};
#pragma unroll
    for (int kb = 0; kb < 4; ++kb) {
      bf16x8 a = *(const bf16x8*)(WS + (i0 + fr) * 272 + (kb * 32 + fq * 8) * 2);
#pragma unroll
      for (int n = 0; n < 8; ++n) {
        bf16x8 b = *(const bf16x8*)(VNT + (n * 16 + fr) * 272 + (kb * 32 + fq * 8) * 2);
        acc[n] = MFMA16(b, a, acc[n]);
      }
    }
    const int i = i0 + fr;
    const int tok = tok_of(base, C * 128 + i, colm);
    const float bs = p.b_s[(j * 4 + hb) * 128 + i];
    bf16_t* zr = Z + (size_t)tok * ZS_E;
#pragma unroll
    for (int n = 0; n < 8; ++n) {
      const int d = hb * 128 + n * 16 + fq * 4;
      uint2 u = *(const uint2*)(zr + 1024 + d), gb = *(const uint2*)(zr + 2560 + d);
      float o0 = bflo(u.x) * (acc[n][0] + bs) * silu_f(bflo(gb.x));
      float o1 = bfhi(u.x) * (acc[n][1] + bs) * silu_f(bfhi(gb.x));
      float o2 = bflo(u.y) * (acc[n][2] + bs) * silu_f(bflo(gb.y));
      float o3 = bfhi(u.y) * (acc[n][3] + bs) * silu_f(bfhi(gb.y));
      uint2 o; o.x = pk2(o0, o1); o.y = pk2(o2, o3);
      *(uint2*)(zr + 1024 + d) = o;
    }
  }
  __syncthreads();
}

template <int NCHK, int BATCH>
__device__ __forceinline__ void scan_chain(float* ST, const float* DEC, int cidx0, int h, int dir, int e, float S, float& Sout) {
  const int k = e >> 7;
#pragma unroll 1
  for (int s0 = 0; s0 < NCHK; s0 += BATCH) {
    float hv[BATCH], dv[BATCH];
#pragma unroll
    for (int i = 0; i < BATCH; ++i) {
      const int step = s0 + i, Cc = dir == 0 ? step : NCHK - 1 - step;
      const size_t idx = (size_t)(((cidx0 + Cc) * 4 + h) * 2 + dir);
      hv[i] = ST[idx * 8192 + e]; dv[i] = DEC[idx * 64 + k];
    }
#pragma unroll
    for (int i = 0; i < BATCH; ++i) {
      const int step = s0 + i, Cc = dir == 0 ? step : NCHK - 1 - step;
      const size_t idx = (size_t)(((cidx0 + Cc) * 4 + h) * 2 + dir);
      ST[idx * 8192 + e] = S;
      S = dv[i] * S + hv[i];
    }
  }
  Sout = S;
}
__device__ void m2_phase(const Params& p, int l) {
  const int tid = otid(), j = l >> 1;
  float* ST = (float*)(p.ws + WS_H); const float* DEC = (const float*)(p.ws + WS_DEC);
  for (int item = obid(); item < 512 + 4096; item += ogdim()) {
    float S, So;
    if (item < 512) {
      const int chain = item >> 4, slab = item & 15, b = chain >> 3, h = (chain >> 1) & 3, dir = chain & 1, e = slab * 512 + tid;
      S = p.state_gla[((size_t)((b * 2 + j) * 2 + dir) * 4 + h) * 8192 + e];
      scan_chain<32, 8>(ST, DEC, 64 + b * 32, h, dir, e, S, So);
    } else {
      const int it2 = item - 512, chain = it2 >> 4, slab = it2 & 15, b = chain >> 3, h = (chain >> 1) & 3, dir = chain & 1, e = slab * 512 + tid;
      S = 0.f;
      scan_chain<2, 2>(ST, DEC, b * 2, h, dir, e, S, So);
      p.out[(size_t)NTOK * DM + ((size_t)((b * 2 + j) * 2 + dir) * 4 + h) * 8192 + e] = So;
    }
  }
}

__device__ void m3_gla_item(const Params& p, int l, int item) {
  char* smem = g_smem;
  const int tid = otid(), lane = tid & 63, wid = tid >> 6, fr = lane & 15, fq = lane >> 4;
  const int cidx = item >> 2, h = item & 3, j = l >> 1;
  int base, T, C; chunk_info(cidx, base, T, C);
  const bool colm = (l >= 2) && (T == 4096);
  bf16_t* Z = (bf16_t*)(p.ws + WS_Z);
  char* AT = smem; char* VST = smem + 67584; char* KPf = smem + 67584; char* KPb = smem + 67584 + 18432;
  float* LR = (float*)(smem + 135168); float* SEG = (float*)(smem + 135168 + 16384);
  const float* ST = (const float*)(p.ws + WS_H);
  load_lr(Z, base, C, colm, LR, tid);
  __syncthreads();
  {
    float bf[16], bb[16], totf, totb;
    gla_cum(p, j, h, LR, SEG, lane, wid, bf, bb, totf, totb);
    const int k = lane, seg = wid;
#pragma unroll
    for (int i = 0; i < 16; ++i) {
      const int pos = seg * 16 + i;
      const int tok = tok_of(base, C * 128 + pos, colm);
      const float q = bf2f(Z[(size_t)tok * ZS_E + h * 64 + k]) * 0.125f;
      const float kk = bf2f(Z[(size_t)tok * ZS_E + 256 + h * 64 + k]);
      *(bf16_t*)(AT + pos * 528 + (128 + k) * 2) = f2bf(q * __expf(bf[i]));
      *(bf16_t*)(AT + pos * 528 + (192 + k) * 2) = f2bf(q * __expf(bb[i]));
      *(bf16_t*)(KPf + pos * 144 + k * 2) = f2bf(kk * __expf(-bf[i]));
      *(bf16_t*)(KPb + pos * 144 + k * 2) = f2bf(kk * __expf(-bb[i]));
    }
  }
  __syncthreads();
  const int i0 = wid * 16;
  {
    f32x4 pf[8], pb[8];
#pragma unroll
    for (int n = 0; n < 8; ++n) { pf[n] = (f32x4){0.f, 0.f, 0.f, 0.f}; pb[n] = (f32x4){0.f, 0.f, 0.f, 0.f}; }
#pragma unroll
    for (int kb = 0; kb < 2; ++kb) {
      bf16x8 aqf = *(const bf16x8*)(AT + (i0 + fr) * 528 + (128 + kb * 32 + fq * 8) * 2);
      bf16x8 aqb = *(const bf16x8*)(AT + (i0 + fr) * 528 + (192 + kb * 32 + fq * 8) * 2);
#pragma unroll
      for (int n = 0; n < 8; ++n) {
        bf16x8 bkf = *(const bf16x8*)(KPf + (n * 16 + fr) * 144 + (kb * 32 + fq * 8) * 2);
        bf16x8 bkb = *(const bf16x8*)(KPb + (n * 16 + fr) * 144 + (kb * 32 + fq * 8) * 2);
        pf[n] = MFMA16(bkf, aqf, pf[n]);
        pb[n] = MFMA16(bkb, aqb, pb[n]);
      }
    }
    const int i = i0 + fr;
#pragma unroll
    for (int n = 0; n < 8; ++n) {
      float a[4];
#pragma unroll
      for (int r = 0; r < 4; ++r) { const int jj = n * 16 + fq * 4 + r; a[r] = (jj <= i ? pf[n][r] : 0.f) + (jj >= i ? pb[n][r] : 0.f); }
      uint2 o; o.x = pk2(a[0], a[1]); o.y = pk2(a[2], a[3]);
      *(uint2*)(AT + i * 528 + (n * 16 + fq * 4) * 2) = o;
    }
  }
  __syncthreads();
  fill_T128(Z, ZS_E, base, C, colm, 512 + h * 128, VST, 528, tid);
#pragma unroll
  for (int dir = 0; dir < 2; ++dir) {
    const float* s = ST + (size_t)((cidx * 4 + h) * 2 + dir) * 8192;
#pragma unroll
    for (int ii = 0; ii < 4; ++ii) {
      const int id = tid + ii * 512, k = id >> 5, v4 = id & 31;
      f32x4 sv = *(const f32x4*)(s + k * 128 + v4 * 4);
#pragma unroll
      for (int e = 0; e < 4; ++e) *(bf16_t*)(VST + (v4 * 4 + e) * 528 + (128 + dir * 64 + k) * 2) = f2bf(sv[e]);
    }
  }
  __syncthreads();
  {
    f32x4 o[8];
#pragma unroll
    for (int n = 0; n < 8; ++n) o[n] = (f32x4){0.f, 0.f, 0.f, 0.f};
#pragma unroll
    for (int kb = 0; kb < 8; ++kb) {
      bf16x8 a = *(const bf16x8*)(AT + (i0 + fr) * 528 + (kb * 32 + fq * 8) * 2);
#pragma unroll
      for (int n = 0; n < 8; ++n) {
        bf16x8 b = *(const bf16x8*)(VST + (n * 16 + fr) * 528 + (kb * 32 + fq * 8) * 2);
        o[n] = MFMA16(b, a, o[n]);
      }
    }
    float ss = 0.f;
#pragma unroll
    for (int n = 0; n < 8; ++n) ss += o[n][0] * o[n][0] + o[n][1] * o[n][1] + o[n][2] * o[n][2] + o[n][3] * o[n][3];
    ss += __shfl_xor(ss, 16); ss += __shfl_xor(ss, 32);
    const float rstd = rsqrtf(ss * (1.f / 128.f) + EPS);
    const int tok = tok_of(base, C * 128 + i0 + fr, colm);
    bf16_t* zr = Z + (size_t)tok * ZS_E;
#pragma unroll
    for (int n = 0; n < 8; ++n) {
      const int v0 = n * 16 + fq * 4;
      uint2 ga = *(const uint2*)(zr + 1536 + h * 128 + v0);
      f32x4 g = *(const f32x4*)(p.gla_norm_g + j * 128 + v0);
      float r0 = o[n][0] * rstd * g[0] * silu_f(bflo(ga.x));
      float r1 = o[n][1] * rstd * g[1] * silu_f(bfhi(ga.x));
      float r2 = o[n][2] * rstd * g[2] * silu_f(bflo(ga.y));
      float r3 = o[n][3] * rstd * g[3] * silu_f(bfhi(ga.y));
      uint2 ov; ov.x = pk2(r0, r1); ov.y = pk2(r2, r3);
      *(uint2*)(zr + 512 + h * 128 + v0) = ov;
    }
  }
  __syncthreads();
}

__device__ void odd_item(const Params& p, int l, int item) {
  char* smem = g_smem;
  const int tid = otid(), lane = tid & 63, wid = tid >> 6, fr = lane & 15, fq = lane >> 4;
  const int cidx = item >> 2, g = item & 3, j = l >> 1;
  int base, T, C; chunk_info(cidx, base, T, C);
  const bool colm = (l >= 2) && (T == 4096);
  bf16_t* Z = (bf16_t*)(p.ws + WS_Z);
  char* XC = smem; char* PL = smem + 39168; char* WP = smem + 73984;
  const int p0 = C * 128;
  for (int id = tid; id < 144 * 16; id += 512) {
    const int r = id >> 4, cc = id & 15, pos = p0 - 8 + r;
    uint4 v = {0u, 0u, 0u, 0u};
    if (pos >= 0 && pos < T) v = *(const uint4*)(Z + (size_t)tok_of(base, pos, colm) * ZS_O + g * 128 + cc * 8);
    *(uint4*)(XC + r * 272 + cc * 16) = v;
  }
  {
    const float* w = p.w_pool + (size_t)(j * 4 + g) * 16384;
#pragma unroll
    for (int ii = 0; ii < 8; ++ii) {
      const int id = tid + ii * 512, c = id >> 5, d4 = id & 31;
      f32x4 v = *(const f32x4*)(w + c * 128 + d4 * 4);
#pragma unroll
      for (int e = 0; e < 4; ++e) *(bf16_t*)(WP + (d4 * 4 + e) * 272 + c * 2) = f2bf(v[e]);
    }
  }
  __syncthreads();
  {
    const int hw = 1 << g;
#pragma unroll
    for (int ii = 0; ii < 4; ++ii) {
      const int id = tid + ii * 512, t = id >> 4, cc = id & 15, pos = p0 + t;
      const int lo = max(pos - hw, 0), hi = min(pos + hw, T);
      float s[8];
#pragma unroll
      for (int e = 0; e < 8; ++e) s[e] = 0.f;
      for (int pp = lo; pp < hi; ++pp) {
        uint4 v = *(const uint4*)(XC + (pp - p0 + 8) * 272 + cc * 16);
        s[0] += bflo(v.x); s[1] += bfhi(v.x); s[2] += bflo(v.y); s[3] += bfhi(v.y); s[4] += bflo(v.z); s[5] += bfhi(v.z); s[6] += bflo(v.w); s[7] += bfhi(v.w);
      }
      const float inv = 1.f / (float)(hi - lo);
      uint4 cv = *(const uint4*)(XC + (t + 8) * 272 + cc * 16);
      uint4 o;
      o.x = pk2(s[0] * inv - bflo(cv.x), s[1] * inv - bfhi(cv.x));
      o.y = pk2(s[2] * inv - bflo(cv.y), s[3] * inv - bfhi(cv.y));
      o.z = pk2(s[4] * inv - bflo(cv.z), s[5] * inv - bfhi(cv.z));
      o.w = pk2(s[6] * inv - bflo(cv.w), s[7] * inv - bfhi(cv.w));
      *(uint4*)(PL + t * 272 + cc * 16) = o;
    }
  }
  __syncthreads();
  {
    const int i0 = wid * 16;
    f32x4 acc[8];
#pragma unroll
    for (int n = 0; n < 8; ++n) acc[n] = (f32x4){0.f, 0.f, 0.f, 0.f};
#pragma unroll
    for (int kb = 0; kb < 4; ++kb) {
      bf16x8 a = *(const bf16x8*)(PL + (i0 + fr) * 272 + (kb * 32 + fq * 8) * 2);
#pragma unroll
      for (int n = 0; n < 8; ++n) {
        bf16x8 b = *(const bf16x8*)(WP + (n * 16 + fr) * 272 + (kb * 32 + fq * 8) * 2);
        acc[n] = MFMA16(b, a, acc[n]);
      }
    }
    const int tok = tok_of(base, p0 + i0 + fr, colm);
    bf16_t* zr = Z + (size_t)tok * ZS_O;
#pragma unroll
    for (int n = 0; n < 8; ++n) {
      const int d = g * 128 + n * 16 + fq * 4;
      uint2 gc = *(const uint2*)(zr + 512 + d);
      f32x4 ps = *(const f32x4*)(p.pool_scale + j * 512 + d);
      float r0 = acc[n][0] * ps[0] * silu_f(bflo(gc.x));
      float r1 = acc[n][1] * ps[1] * silu_f(bfhi(gc.x));
      float r2 = acc[n][2] * ps[2] * silu_f(bflo(gc.y));
      float r3 = acc[n][3] * ps[3] * silu_f(bfhi(gc.y));
      uint2 o; o.x = pk2(r0, r1); o.y = pk2(r2, r3);
      *(uint2*)(zr + 512 + d) = o;
    }
  }
  {
#pragma unroll
    for (int ii = 0; ii < 4; ++ii) {
      const int id = tid + ii * 512, t = id >> 4, cc = id & 15, pos = p0 + t, ch = g * 128 + cc * 8;
      float u[3][8];
#pragma unroll
      for (int dd = 0; dd < 3; ++dd) {
        const int pp = pos - 1 + dd;
        if (pp >= 0 && pp < T) {
          const bf16_t* zr = Z + (size_t)tok_of(base, pp, colm) * ZS_O;
          uint4 xd = *(const uint4*)(zr + 1536 + ch), cd = *(const uint4*)(zr + 2048 + ch);
          u[dd][0] = bflo(xd.x) * bflo(cd.x); u[dd][1] = bfhi(xd.x) * bfhi(cd.x); u[dd][2] = bflo(xd.y) * bflo(cd.y); u[dd][3] = bfhi(xd.y) * bfhi(cd.y);
          u[dd][4] = bflo(xd.z) * bflo(cd.z); u[dd][5] = bfhi(xd.z) * bfhi(cd.z); u[dd][6] = bflo(xd.w) * bflo(cd.w); u[dd][7] = bfhi(xd.w) * bfhi(cd.w);
        } else {
#pragma unroll
          for (int e = 0; e < 8; ++e) u[dd][e] = 0.f;
        }
      }
      bf16_t* zr = Z + (size_t)tok_of(base, pos, colm) * ZS_O;
      uint4 bd = *(const uint4*)(zr + 1024 + ch), gd = *(const uint4*)(zr + 2560 + ch);
      const float* w0 = p.w_conv + (size_t)(j * 3 + 0) * 512 + ch;
      const float* w1 = p.w_conv + (size_t)(j * 3 + 1) * 512 + ch;
      const float* w2 = p.w_conv + (size_t)(j * 3 + 2) * 512 + ch;
      float o[8];
#pragma unroll
      for (int e = 0; e < 8; ++e) {
        const float y = u[0][e] * w0[e] + u[1][e] * w1[e] + u[2][e] * w2[e];
        o[e] = bf2f(bfel(bd, e)) * y * silu_f(bf2f(bfel(gd, e)));
      }
      uint4 ov; ov.x = pk2(o[0], o[1]); ov.y = pk2(o[2], o[3]); ov.z = pk2(o[4], o[5]); ov.w = pk2(o[6], o[7]);
      *(uint4*)(zr + 1024 + ch) = ov;
    }
  }
  __syncthreads();
}

__device__ __forceinline__ void run_phase(const Params& p, int ph, int l) {
  const bool even = (l & 1) == 0;
  const int j = l >> 1;
  switch (ph) {
    case 0: prep_phase(p); break;
    case 1: norm_phase(p, l); break;
    case 2:
      gemm_phase<0>(p, (const bf16_t*)(p.ws + WS_H), DM,
                    even ? (const bf16_t*)(p.ws + WS_WINE) + (size_t)j * NPAD_E * 1024 : (const bf16_t*)(p.ws + WS_WINO) + (size_t)j * 3072 * 1024,
                    even ? 13 : 12, l, even ? ZS_E : ZS_O);
      break;
    case 3:
      if (even) {
        for (int item = obid(); item < 1536; item += ogdim()) { if (item < 768) m1_gla_item(p, l, item); else sgu_item(p, l, item - 768); }
      } else {
        for (int item = obid(); item < 768; item += ogdim()) odd_item(p, l, item);
      }
      break;
    case 4: m2_phase(p, l); break;
    case 5: for (int item = obid(); item < 768; item += ogdim()) m3_gla_item(p, l, item); break;
    case 6:
      gemm_phase<1>(p, (const bf16_t*)(p.ws + WS_Z) + 512, even ? ZS_E : ZS_O, (const bf16_t*)(p.ws + WS_WOUT) + (size_t)l * 1024 * 1024, 4, l, 0);
      break;
  }
}

template <int PH> __global__ void __launch_bounds__(512, 2) k_phase(Params p, int l) { run_phase(p, PH, l); }

#define XB_TMO      128
#define XB_XCNT(j)  (256  + 64 * (j))
#define XB_XSUB(j)  (1280 + 64 * (j))
#define XB_XGEN(j)  (2304 + 64 * (j))
#define XB_TOP      3328
#define XB_TOPGEN   3392
#define XCD_BAR_WORDS 3456
#define XB_SPIN_CAP (1u << 18)
#define LAS __attribute__((address_space(3)))
__device__ __forceinline__ unsigned xb_ld(unsigned* p)              { return __hip_atomic_load(p, __ATOMIC_RELAXED, __HIP_MEMORY_SCOPE_AGENT); }
__device__ __forceinline__ unsigned xb_add(unsigned* p, unsigned v) { return __hip_atomic_fetch_add(p, v, __ATOMIC_RELAXED, __HIP_MEMORY_SCOPE_AGENT); }
__device__ __forceinline__ unsigned xb_xcc_id() { return (unsigned)__builtin_amdgcn_s_getreg((3 << 11) | 20) & 0xFu; }
#define XB_SPIN(cond, bar) do { unsigned _sp = 0; while (cond) { __builtin_amdgcn_s_sleep(1); \
    if ((++_sp & 255u) == 0u) { if (xb_ld(&(bar)[XB_TMO])) break; if (_sp > XB_SPIN_CAP) { atomicAdd(&(bar)[XB_TMO], 1u); break; } } } } while (0)
struct XcdBarrier { unsigned* bar; unsigned x; volatile LAS unsigned* st; };
__device__ __forceinline__ XcdBarrier xcd_barrier_post(unsigned* bar, volatile LAS unsigned* st) {
    XcdBarrier b; b.bar = bar; b.x = xb_xcc_id(); b.st = st;
    if (threadIdx.x == 0) (void)xb_add(&bar[XB_XCNT(b.x)], 1u);
    return b;
}
__device__ __forceinline__ void xcd_barrier_complete(unsigned* bar, unsigned x, unsigned& nloc, unsigned& nx) {
    const unsigned G = gridDim.x * gridDim.y * gridDim.z;
    unsigned sum, cnt, mine, sp = 0u;
    for (;;) {
        sum = 0u; cnt = 0u; mine = 0u;
#pragma unroll
        for (unsigned j = 0; j < 16; ++j) { const unsigned c = xb_ld(&bar[XB_XCNT(j)]); sum += c; cnt += (c > 0u) ? 1u : 0u; mine = (j == x) ? c : mine; }
        if (sum == G) break;
        __builtin_amdgcn_s_sleep(1);
        if ((++sp & 255u) == 0u) { if (xb_ld(&bar[XB_TMO])) break; if (sp > XB_SPIN_CAP) { atomicAdd(&bar[XB_TMO], 1u); break; } }
    }
    nloc = mine > 0u ? mine : 1u; nx = cnt > 0u ? cnt : 1u;
}
__device__ __forceinline__ void xcd_barrier(const XcdBarrier& b0) {
    asm volatile("s_waitcnt vmcnt(0)" ::: "memory");
    __syncthreads();
    if (threadIdx.x == 0) {
        XcdBarrier b; b.st = b0.st; b.x = xb_xcc_id();
        unsigned* bar = b0.bar; asm volatile("" : "+s"(bar));
        b.bar = bar;
        __builtin_amdgcn_s_waitcnt(0);
        unsigned nloc = b.st[0], nx = b.st[1];
        if (nloc == 0u) { xcd_barrier_complete(bar, b.x, nloc, nx); b.st[0] = nloc; b.st[1] = nx; }
        const unsigned old = xb_add(&bar[XB_XSUB(b.x)], 1u);
        const unsigned gen = old / nloc;
        if (old + 1u == (gen + 1u) * nloc) {
            __builtin_amdgcn_fence(__ATOMIC_RELEASE, "agent");
            asm volatile("s_waitcnt vmcnt(0)" ::: "memory");
            const unsigned og = xb_add(&bar[XB_TOP], 1u);
            const unsigned tg = og / nx;
            if (og + 1u == (tg + 1u) * nx) xb_add(&bar[XB_TOPGEN], 1u);
            else XB_SPIN(xb_ld(&bar[XB_TOPGEN]) == tg, bar);
            __builtin_amdgcn_fence(__ATOMIC_ACQUIRE, "agent");
            xb_add(&bar[XB_XGEN(b.x)], 1u);
            asm volatile("s_waitcnt vmcnt(0)" ::: "memory");
        } else {
            XB_SPIN(xb_ld(&bar[XB_XGEN(b.x)]) == gen, bar);
            __builtin_amdgcn_fence(__ATOMIC_ACQUIRE, "agent");
            asm volatile("s_waitcnt vmcnt(0)" ::: "memory");
        }
    }
    __syncthreads();
}

#if MEGA
__global__ void __launch_bounds__(512, 2) k_mega(Params p) {
  cg::grid_group grid = cg::this_grid();
  volatile LAS unsigned* st = (volatile LAS unsigned*)(g_smem + 155648);
  if (threadIdx.x == 0) { st[0] = 0u; st[1] = 0u; }
  __syncthreads();
  XcdBarrier xb = xcd_barrier_post((unsigned*)(p.ws + WS_BAR), st);
#define GSYNC() xcd_barrier(xb)
  run_phase(p, 0, 0); grid.sync();
  run_phase(p, 1, 0); GSYNC();
#pragma unroll 1
  for (int l = 0; l < 4; ++l) {
    run_phase(p, 2, l); GSYNC();
    run_phase(p, 3, l); GSYNC();
    if ((l & 1) == 0) {
      run_phase(p, 4, l); GSYNC();
      run_phase(p, 5, l); GSYNC();
    }
    run_phase(p, 6, l); GSYNC();
    run_phase(p, 1, l + 1);
    if (l < 3) GSYNC();
  }
}
#endif

extern "C" void kernel_launch(void* const* d_in, const int* in_sizes, int n_in, void* d_out, int out_size, void* d_ws, size_t ws_size, hipStream_t stream) {
  Params p{};
  p.x_prompt = (const float*)d_in[0]; p.x_sample = (const float*)d_in[1]; p.c = (const float*)d_in[2]; p.state_gla = (const float*)d_in[3];
  p.c_ctx = (const float*)d_in[4]; p.w_ada = (const float*)d_in[5]; p.b_ada = (const float*)d_in[6]; p.norm_g = (const float*)d_in[7];
  p.w_in_even = (const float*)d_in[8]; p.w_in_odd = (const float*)d_in[9]; p.w_out = (const float*)d_in[10]; p.w_gk = (const float*)d_in[11];
  p.b_gk = (const float*)d_in[12]; p.gla_norm_g = (const float*)d_in[13]; p.sgu_norm_g = (const float*)d_in[14]; p.w_s = (const float*)d_in[15];
  p.b_s = (const float*)d_in[16]; p.w_pool = (const float*)d_in[17]; p.pool_scale = (const float*)d_in[18]; p.w_conv = (const float*)d_in[19];
  p.final_norm_g = (const float*)d_in[20];
  p.out = (float*)d_out; p.ws = (char*)d_ws;
#if MEGA
  static int grid_blocks = 0;
  if (!grid_blocks) {
    int dev = 0, cus = 0, per_cu = 0;
    hipGetDevice(&dev);
    hipDeviceGetAttribute(&cus, hipDeviceAttributeMultiprocessorCount, dev);
    hipOccupancyMaxActiveBlocksPerMultiprocessor(&per_cu, k_mega, 512, 0);
    if (per_cu < 1) per_cu = 1;
    grid_blocks = cus;
  }
  hipMemsetAsync((char*)d_ws + WS_BAR, 0, 16384, stream);
  void* args[] = {&p};
  hipError_t e = hipLaunchCooperativeKernel((void*)k_mega, dim3(grid_blocks), dim3(512), args, 0, stream);
  if (e != hipSuccess) fprintf(stderr, "cooperative launch failed: %s (grid %d)\n", hipGetErrorString(e), grid_blocks);
#else
  const int G = 256;
  k_phase<0><<<G, 512, 0, stream>>>(p, 0);
  k_phase<1><<<G, 512, 0, stream>>>(p, 0);
  for (int l = 0; l < 4; ++l) {
    k_phase<2><<<G, 512, 0, stream>>>(p, l);
    k_phase<3><<<G, 512, 0, stream>>>(p, l);
    if ((l & 1) == 0) { k_phase<4><<<G, 512, 0, stream>>>(p, l); k_phase<5><<<G, 512, 0, stream>>>(p, l); }
    k_phase<6><<<G, 512, 0, stream>>>(p, l);
    k_phase<1><<<G, 512, 0, stream>>>(p, l + 1);
  }
#endif
}
```

```cpp
#include <hip/hip_runtime.h>
#include <hip/hip_cooperative_groups.h>
#include <stdint.h>
#include <stdio.h>
namespace cg = cooperative_groups;

#ifndef MEGA
#define MEGA 1
#endif

typedef unsigned short bf16_t;
typedef short bf16x8 __attribute__((ext_vector_type(8)));
typedef float f32x4 __attribute__((ext_vector_type(4)));
typedef unsigned u32x4 __attribute__((ext_vector_type(4)));
typedef unsigned u32x2 __attribute__((ext_vector_type(2)));

constexpr int NTOK = 24576;
constexpr int NPROMPT = 8192;
constexpr int DM = 1024;
constexpr int ZS_E = 3104, ZS_O = 3104, NPAD_E = 3328;
constexpr float EPS = 1e-6f;
constexpr int LDS_BYTES = 155648 + 16;
constexpr int NCH = 192;

constexpr size_t WS_ADA = 0;
constexpr size_t WS_DEC = 262144;
constexpr size_t WS_BAR = 720896;
constexpr size_t WS_WPT = 786432;
constexpr size_t WS_WINE = 1048576;
constexpr size_t WS_WINO = WS_WINE + 2ull * 3328 * 1024 * 2;
constexpr size_t WS_WOUT = WS_WINO + 2ull * 3072 * 1024 * 2;
constexpr size_t WS_SSV = 35651584;
constexpr size_t WS_WSB = WS_SSV + 786432;
constexpr size_t WS_Z = 36700160;
constexpr size_t WS_SSP = 241172480;
constexpr size_t WS_SW = WS_SSP + 1572864;
constexpr size_t WS_ST = WS_SW + 266240;
constexpr size_t WS_H = 190840832;

struct Params {
  const float *x_prompt, *x_sample, *c, *state_gla, *c_ctx, *w_ada, *b_ada, *norm_g, *w_in_even, *w_in_odd, *w_out, *w_gk, *b_gk,
      *gla_norm_g, *sgu_norm_g, *w_s, *b_s, *w_pool, *pool_scale, *w_conv, *final_norm_g;
  float* out;
  char* ws;
  int use_cg_sync;
  int pad_;
};

__shared__ __attribute__((aligned(1024))) char g_smem[LDS_BYTES];

__device__ __forceinline__ float bf2f(bf16_t b) { return __uint_as_float(((uint32_t)b) << 16); }
__device__ __forceinline__ float bflo(uint32_t w) { return __uint_as_float(w << 16); }
__device__ __forceinline__ float bfhi(uint32_t w) { return __uint_as_float(w & 0xffff0000u); }
__device__ __forceinline__ bf16_t f2bf(float f) { uint32_t u = __float_as_uint(f); u += 0x7fffu + ((u >> 16) & 1u); return (bf16_t)(u >> 16); }
__device__ __forceinline__ uint32_t pk2(float lo, float hi) { uint32_t r; asm("v_cvt_pk_bf16_f32 %0, %1, %2" : "=v"(r) : "v"(lo), "v"(hi)); return r; }
__device__ __forceinline__ float silu_f(float x) { return x / (1.f + __expf(-x)); }
__device__ __forceinline__ float logsig(float x) { return fminf(x, 0.f) - __logf(1.f + __expf(-fabsf(x))); }
__device__ __forceinline__ bf16_t bfel(const uint4& v, int e) { uint32_t w = (e >> 1) == 0 ? v.x : (e >> 1) == 1 ? v.y : (e >> 1) == 2 ? v.z : v.w; return (bf16_t)((e & 1) ? (w >> 16) : (w & 0xffffu)); }

__device__ __forceinline__ void chunk_info(int cidx, int& base, int& T, int& C) {
  if (cidx < 64) { C = cidx & 1; T = 256; base = (cidx >> 1) * 256; }
  else { int cs = cidx - 64; C = cs & 31; T = 4096; base = NPROMPT + (cs >> 5) * 4096; }
}
__device__ __forceinline__ int tok_of(int base, int p, bool colm) { return base + (colm ? ((p & 63) * 64 + (p >> 6)) : p); }
__device__ __forceinline__ int cond_of(int row) { return row < NPROMPT ? 0 : 1 + ((row - NPROMPT) >> 12); }

__device__ __forceinline__ int otid() { int t = threadIdx.x; asm volatile("" : "+v"(t)); return t; }
__device__ __forceinline__ int obid() { int b = blockIdx.x; asm volatile("" : "+s"(b)); return b; }
__device__ __forceinline__ int ogdim() { int b = gridDim.x; asm volatile("" : "+s"(b)); return b; }

#define SCHED_FENCE() asm volatile("" ::: "memory")
__device__ __forceinline__ int slot32(int c) { return (c & ~31) | (((c >> 2) & 1) << 4) | (((c >> 3) & 3) << 2) | (c & 3); }
#define MFMA16(a, b, c) __builtin_amdgcn_mfma_f32_16x16x32_bf16((a), (b), (c), 0, 0, 0)

__device__ __forceinline__ int src_col_even(int n) {
  if (n < 1024) return n;
  if (n < 1536) return 1568 + (n - 1024);
  if (n < 2048) return 1024 + (n - 1536);
  if (n < 2560) return 2080 + (n - 2048);
  if (n < 3072) return 2592 + (n - 2560);
  if (n < 3104) return 1536 + (n - 3072);
  return -1;
}
__device__ __forceinline__ int src_col_odd(int n) {
  if (n >= 1024 && n < 1536) return n + 512;
  if (n >= 1536 && n < 2048) return n - 512;
  return n;
}

struct TileP { const float* src; bf16_t* dst; int nsrc, kind, kdim, n0, k0; };
__device__ __forceinline__ void tile_params(const Params& p, int t, TileP& q) {
  int nt, kt; q.kdim = 1024;
  if (t < 1664) { int j = t / 832, r = t % 832; nt = r >> 4; kt = r & 15; q.src = p.w_in_even + (size_t)j * 1024 * 3104; q.nsrc = 3104; q.dst = (bf16_t*)(p.ws + WS_WINE) + (size_t)j * NPAD_E * 1024; q.kind = 0; }
  else if (t < 3200) { int tt = t - 1664; int j = tt / 768, r = tt % 768; nt = r >> 4; kt = r & 15; q.src = p.w_in_odd + (size_t)j * 1024 * 3072; q.nsrc = 3072; q.dst = (bf16_t*)(p.ws + WS_WINO) + (size_t)j * 3072 * 1024; q.kind = 1; }
  else if (t >= 4224) { int tt = t - 4224; int m = tt >> 2, r = tt & 3; nt = r >> 1; kt = r & 1; q.src = p.w_pool + (size_t)m * 16384; q.nsrc = 128; q.dst = (bf16_t*)(p.ws + WS_WPT) + (size_t)m * 16384; q.kind = 2; q.kdim = 128; }
  else { int tt = t - 3200; int l = tt >> 8, r = tt & 255; nt = r >> 4; kt = r & 15; q.src = p.w_out + (size_t)l * 1024 * 1024; q.nsrc = 1024; q.dst = (bf16_t*)(p.ws + WS_WOUT) + (size_t)l * 1024 * 1024; q.kind = 2; }
  q.n0 = nt * 64; q.k0 = kt * 64;
}

__device__ void prep_phase(const Params& p) {
  const int tid = otid();
  char* smem = g_smem;
  constexpr int N_ADA = 192, N_TR = (4224 + 32) / 4, N_WS = 32;
  for (int item = obid(); item < N_ADA + N_TR + N_WS; item += ogdim()) {
    if (item >= N_ADA + N_TR) {
      const int e0 = (item - N_ADA - N_TR) * 4096 + tid * 8;
      const f32x4 a = *(const f32x4*)(p.w_s + e0), b = *(const f32x4*)(p.w_s + e0 + 4);
      uint4 o; o.x = pk2(a[0], a[1]); o.y = pk2(a[2], a[3]); o.z = pk2(b[0], b[1]); o.w = pk2(b[2], b[3]);
      *(uint4*)((bf16_t*)(p.ws + WS_WSB) + e0) = o;
    } else if (item < N_ADA) {
      const int l = item / 48, n0 = (item % 48) * 64;
      float* SC = (float*)smem;
      float* RED = (float*)(smem + 20480);
      for (int i = tid; i < 5120; i += 512) {
        int cb = i >> 10, k = i & 1023;
        float v = cb == 0 ? p.c_ctx[k] : p.c[(cb - 1) * 1024 + k];
        SC[i] = silu_f(v);
      }
      __syncthreads();
      const int col = tid & 63, ks = tid >> 6;
      float a0 = 0, a1 = 0, a2 = 0, a3 = 0, a4 = 0;
      const float* w = p.w_ada + (size_t)l * 1024 * 3072 + n0 + col;
#pragma unroll 8
      for (int kk = 0; kk < 128; ++kk) {
        int k = ks * 128 + kk;
        float wv = w[(size_t)k * 3072];
        a0 += SC[k] * wv; a1 += SC[1024 + k] * wv; a2 += SC[2048 + k] * wv; a3 += SC[3072 + k] * wv; a4 += SC[4096 + k] * wv;
      }
      RED[(ks * 5 + 0) * 64 + col] = a0; RED[(ks * 5 + 1) * 64 + col] = a1; RED[(ks * 5 + 2) * 64 + col] = a2;
      RED[(ks * 5 + 3) * 64 + col] = a3; RED[(ks * 5 + 4) * 64 + col] = a4;
      __syncthreads();
      if (tid < 320) {
        int cb = tid >> 6, cc = tid & 63;
        float s = p.b_ada[l * 3072 + n0 + cc];
        for (int q = 0; q < 8; ++q) s += RED[(q * 5 + cb) * 64 + cc];
        ((float*)(p.ws + WS_ADA))[(l * 5 + cb) * 3072 + n0 + cc] = s;
      }
      __syncthreads();
    } else {
      const int g4 = (item - N_ADA) * 4;
      float* T = (float*)smem;
      f32x4 v[4][2];
      const int c4 = tid & 15, kr = tid >> 4;
#pragma unroll
      for (int q = 0; q < 4; ++q) {
        TileP tp; tile_params(p, g4 + q, tp);
        const int nn = tp.n0 + c4 * 4;
        const int sc = tp.kind == 0 ? src_col_even(nn) : tp.kind == 1 ? src_col_odd(nn) : nn;
        const int scl = sc < 0 ? 0 : sc;
#pragma unroll
        for (int ps = 0; ps < 2; ++ps) {
          const f32x4 ld = *(const f32x4*)(tp.src + (size_t)(tp.k0 + kr + ps * 32) * tp.nsrc + scl);
          v[q][ps] = sc < 0 ? (f32x4){0.f, 0.f, 0.f, 0.f} : ld;
        }
      }
      SCHED_FENCE();
#pragma unroll
      for (int q = 0; q < 4; ++q)
#pragma unroll
        for (int ps = 0; ps < 2; ++ps) {
          float* tq = T + q * 4160 + (kr + ps * 32) * 65 + c4 * 4;
          tq[0] = v[q][ps][0]; tq[1] = v[q][ps][1]; tq[2] = v[q][ps][2]; tq[3] = v[q][ps][3];
        }
      __syncthreads();
#pragma unroll
      for (int q = 0; q < 4; ++q) {
        TileP tp; tile_params(p, g4 + q, tp);
        const float* tq = T + q * 4160;
        const int n = tid >> 3, kc = tid & 7;
        uint4 o;
        o.x = pk2(tq[(kc * 8 + 0) * 65 + n], tq[(kc * 8 + 1) * 65 + n]);
        o.y = pk2(tq[(kc * 8 + 2) * 65 + n], tq[(kc * 8 + 3) * 65 + n]);
        o.z = pk2(tq[(kc * 8 + 4) * 65 + n], tq[(kc * 8 + 5) * 65 + n]);
        o.w = pk2(tq[(kc * 8 + 6) * 65 + n], tq[(kc * 8 + 7) * 65 + n]);
        *(uint4*)(tp.dst + (size_t)(tp.n0 + n) * tp.kdim + tp.k0 + kc * 8) = o;
      }
      __syncthreads();
    }
  }
}

__device__ void final_norm_phase(const Params& p) {
  const int tid = otid(), lane = tid & 63, wid = tid >> 6;
  const bf16_t* H = (const bf16_t*)(p.ws + WS_H);
  const float* SSP = (const float*)(p.ws + WS_SSP);
  f32x4 g[4];
#pragma unroll
  for (int i = 0; i < 2; ++i) { g[2 * i] = *(const f32x4*)(p.final_norm_g + i * 512 + lane * 8); g[2 * i + 1] = *(const f32x4*)(p.final_norm_g + i * 512 + lane * 8 + 4); }
#pragma unroll 2
  for (int row = obid() * 8 + wid; row < NTOK; row += ogdim() * 8) {
    const u32x4 h0 = *(const u32x4*)(H + (size_t)row * DM + lane * 8), h1 = *(const u32x4*)(H + (size_t)row * DM + 512 + lane * 8);
    float ss = SSP[(size_t)row * 16 + (lane & 15)];
    ss += __shfl_xor(ss, 8); ss += __shfl_xor(ss, 4); ss += __shfl_xor(ss, 2); ss += __shfl_xor(ss, 1);
    const float rstd = rsqrtf(ss * (1.f / 1024.f) + EPS);
    float* yo = p.out + (size_t)row * DM + lane * 8;
    *(f32x4*)(yo) = (f32x4){bflo(h0[0]) * rstd * g[0][0], bfhi(h0[0]) * rstd * g[0][1], bflo(h0[1]) * rstd * g[0][2], bfhi(h0[1]) * rstd * g[0][3]};
    *(f32x4*)(yo + 4) = (f32x4){bflo(h0[2]) * rstd * g[1][0], bfhi(h0[2]) * rstd * g[1][1], bflo(h0[3]) * rstd * g[1][2], bfhi(h0[3]) * rstd * g[1][3]};
    *(f32x4*)(yo + 512) = (f32x4){bflo(h1[0]) * rstd * g[2][0], bfhi(h1[0]) * rstd * g[2][1], bflo(h1[1]) * rstd * g[2][2], bfhi(h1[1]) * rstd * g[2][3]};
    *(f32x4*)(yo + 516) = (f32x4){bflo(h1[2]) * rstd * g[3][0], bfhi(h1[2]) * rstd * g[3][1], bflo(h1[3]) * rstd * g[3][2], bfhi(h1[3]) * rstd * g[3][3]};
  }
}

__device__ void norm_phase(const Params& p, int l) {
  const int tid = otid(), lane = tid & 63, wid = tid >> 6;
  const float* ada = (const float*)(p.ws + WS_ADA);
  bf16_t* H = (bf16_t*)(p.ws + WS_H);
  float* SSP = (float*)(p.ws + WS_SSP);
  f32x4 gq[4];
#pragma unroll
  for (int i = 0; i < 4; ++i) gq[i] = *(const f32x4*)((l < 4 ? p.norm_g + l * 1024 : p.final_norm_g) + i * 256 + lane * 4);
  for (int row = obid() * 8 + wid; row < NTOK; row += ogdim() * 8) {
    const float* src = (l == 0) ? (row < NPROMPT ? p.x_prompt + (size_t)row * DM : p.x_sample + (size_t)(row - NPROMPT) * DM) : p.out + (size_t)row * DM;
    f32x4 x[4], sq[4];
    float ss = 0.f;
    {
      const float* sh1 = ada + ((l < 4 ? l : 0) * 5 + cond_of(row)) * 3072 + 1024;
#pragma unroll
      for (int i = 0; i < 4; ++i) { x[i] = *(const f32x4*)(src + i * 256 + lane * 4); sq[i] = *(const f32x4*)(sh1 + i * 256 + lane * 4); }
    }
#pragma unroll
    for (int i = 0; i < 4; ++i) ss += x[i][0] * x[i][0] + x[i][1] * x[i][1] + x[i][2] * x[i][2] + x[i][3] * x[i][3];
#pragma unroll
    for (int m = 32; m >= 1; m >>= 1) ss += __shfl_xor(ss, m);
    if (l < 4) {
      const int cb = cond_of(row);
      const float* sh = ada + (l * 5 + cb) * 3072;
      if (lane < 16) SSP[(size_t)row * 16 + lane] = lane == 0 ? ss : 0.f;
#pragma unroll
      for (int i = 0; i < 4; ++i) {
        const int idx = i * 256 + lane * 4;
        const f32x4 g = gq[i], s1 = sq[i];
        uint2 o; o.x = pk2(x[i][0] * g[0] * (1.f + s1[0]), x[i][1] * g[1] * (1.f + s1[1])); o.y = pk2(x[i][2] * g[2] * (1.f + s1[2]), x[i][3] * g[3] * (1.f + s1[3]));
        *(uint2*)(H + (size_t)row * DM + idx) = o;
      }
    } else {
      const float rstd = rsqrtf(ss * (1.f / 1024.f) + EPS);
#pragma unroll
      for (int i = 0; i < 4; ++i) {
        const int idx = i * 256 + lane * 4;
        const f32x4 g = gq[i];
        f32x4 y = {x[i][0] * rstd * g[0], x[i][1] * rstd * g[1], x[i][2] * rstd * g[2], x[i][3] * rstd * g[3]};
        *(f32x4*)(p.out + (size_t)row * DM + idx) = y;
      }
    }
  }
  if (l == 0) {
    float* SW = (float*)(p.ws + WS_SW);
    for (int item = obid(); item < 4 * 52; item += ogdim()) {
      const int ll = item / 52, n0 = (item % 52) * 64, jj = ll >> 1;
      const int ncols = (ll & 1) ? 3072 : NPAD_E;
      if (n0 >= ncols) continue;
      const bf16_t* Wt = (ll & 1) ? (const bf16_t*)(p.ws + WS_WINO) + (size_t)jj * 3072 * 1024 : (const bf16_t*)(p.ws + WS_WINE) + (size_t)jj * NPAD_E * 1024;
      const int n = n0 + (tid >> 3), kp = tid & 7;
      const bf16_t* wr = Wt + (size_t)n * 1024 + kp * 128;
      float a[5] = {0.f, 0.f, 0.f, 0.f, 0.f};
#pragma unroll 4
      for (int c = 0; c < 16; ++c) {
        uint4 w = *(const uint4*)(wr + c * 8);
        float wv[8] = {bflo(w.x), bfhi(w.x), bflo(w.y), bfhi(w.y), bflo(w.z), bfhi(w.z), bflo(w.w), bfhi(w.w)};
#pragma unroll
        for (int cb = 0; cb < 5; ++cb) {
          const float* sh = ada + (ll * 5 + cb) * 3072 + kp * 128 + c * 8;
          f32x4 s0 = *(const f32x4*)sh, s1 = *(const f32x4*)(sh + 4);
          a[cb] += wv[0] * s0[0] + wv[1] * s0[1] + wv[2] * s0[2] + wv[3] * s0[3] + wv[4] * s1[0] + wv[5] * s1[1] + wv[6] * s1[2] + wv[7] * s1[3];
        }
      }
#pragma unroll
      for (int cb = 0; cb < 5; ++cb) { a[cb] += __shfl_xor(a[cb], 1); a[cb] += __shfl_xor(a[cb], 2); a[cb] += __shfl_xor(a[cb], 4); }
      if (kp == 0) {
#pragma unroll
        for (int cb = 0; cb < 5; ++cb) SW[(ll * 5 + cb) * NPAD_E + n] = a[cb];
      }
    }
  }
}

namespace pg8 {
#define PG8_LAS __attribute__((address_space(3)))
constexpr int BM = 256, BK = 64, HALF = 128, HTB = HALF * BK * 2, NXCD = 8, WGM = 8;
__device__ __forceinline__ int lds_byte(int r, int c) { const int st = (r >> 4) * 2 + (c >> 5), rr = r & 15, cc = c & 31, ob = rr * 64 + cc * 2; return st * 1024 + (ob ^ (((ob >> 9) & 1) << 5)); }
__device__ __forceinline__ void stage_rc(int b, int& R, int& C) { const int st = b / 1024, sb = b % 1024, swz = sb ^ (((sb >> 9) & 1) << 5); R = (st >> 1) * 16 + swz / 64; C = (st & 1) * 32 + (swz % 64) / 2; }
__device__ __forceinline__ int perm32(int rho) { const int n = rho >> 4, i = rho & 15; return 8 * (i >> 2) + 4 * n + (i & 3); }
struct Unit { int pm, pn; };
struct StaticOrder {
    int nM, nN, nwg, G, c, mode;
    __device__ void init(int M, int N, int G_, int c_, int mode_) { nM = M / BM; nN = N / BM; nwg = nM * nN; G = G_; c = c_; mode = mode_; }
    __device__ bool next(int i, Unit& u) const {
        if (mode != 0) {
            const int x = c & 7, off = c >> 3;
            if (mode == 1) { if (i > 0) return false; u.pm = 8 * x + (off & 7); u.pn = off >> 3; return true; }
            if (mode == 2) { if (i > 0 || off >= 16) return false; u.pm = 64 + 4 * x + (off & 3); u.pn = off >> 2; return true; }
            if (mode == 3) { if (i > 0 || off < 16) return false; const int o2 = off - 16; u.pm = 8 * x + (o2 & 7); u.pn = o2 >> 3; return true; }
            const int idx = off + 32 * i, n1 = 8 * (nN - 2);
            if (idx < n1) { u.pm = 8 * x + (idx & 7); u.pn = 2 + (idx >> 3); return true; }
            const int idx2 = idx - n1; if (idx2 >= 4 * nN) return false;
            u.pm = 64 + 4 * x + (idx2 & 3); u.pn = idx2 >> 2; return true;
        }
        const long L = (long)i * G + c; if (L >= nwg) return false;
        int wgid = (int)L; { const int q = nwg / NXCD, r = nwg % NXCD, xcd = wgid % NXCD, off = wgid / NXCD; wgid = (xcd < r ? xcd * (q + 1) : r * (q + 1) + (xcd - r) * q) + off; }
        const int nig = WGM * nN, gid = wgid / nig, fm = gid * WGM, gsz = (nM - fm) < WGM ? (nM - fm) : WGM;
        u.pm = fm + ((wgid % nig) % gsz); u.pn = (wgid % nig) / gsz; return true;
    }
};
}

template <int EPI>
__device__ __forceinline__ void gemm_epilogue(const Params& p, const f32x4 (&acc)[2][2][4][2], const pg8::Unit& u, int wr, int wc, int fr, int fq, int l, int zs) {
  using namespace pg8;
  const int row0 = u.pm * BM + wr * 64 + fr, col0 = u.pn * BM + wc * 32 + 8 * fq;
  if (EPI == 0) {
    bf16_t* Zout = (bf16_t*)(p.ws + WS_Z);
    const float* SSP = (const float*)(p.ws + WS_SSP);
    const float* sw = (const float*)(p.ws + WS_SW) + (l * 5 + cond_of(u.pm * BM)) * NPAD_E + col0;
    f32x4 sv[2][2];
#pragma unroll
    for (int bj = 0; bj < 2; ++bj)
#pragma unroll
      for (int n = 0; n < 2; ++n) sv[bj][n] = *(const f32x4*)(sw + bj * HALF + 4 * n);
    const bool vs_tile = ((l & 1) == 0) && (u.pn == 8 || u.pn == 9);
    f32x4 qv[2][4];
#pragma unroll
    for (int ai = 0; ai < 2; ++ai)
#pragma unroll
      for (int m = 0; m < 4; ++m) qv[ai][m] = *(const f32x4*)(SSP + (size_t)(row0 + ai * HALF + m * 16) * 16 + fq * 4);
#pragma unroll
    for (int ai = 0; ai < 2; ++ai)
#pragma unroll
      for (int m = 0; m < 4; ++m) {
        const int row = row0 + ai * HALF + m * 16;
        float ss = (qv[ai][m][0] + qv[ai][m][1]) + (qv[ai][m][2] + qv[ai][m][3]);
        ss += __shfl_xor(ss, 16); ss += __shfl_xor(ss, 32);
        const float rstd = rsqrtf(ss * (1.f / 1024.f) + EPS);
        bf16_t* rowp = Zout + (size_t)row * zs + col0;
        float vss = 0.f;
#pragma unroll
        for (int bj = 0; bj < 2; ++bj) {
          if (col0 + bj * HALF < zs) {
            const f32x4 v0 = acc[ai][bj][m][0], v1 = acc[ai][bj][m][1], s0 = sv[bj][0], s1 = sv[bj][1];
            const f32x4 z0 = {v0[0] * rstd + s0[0], v0[1] * rstd + s0[1], v0[2] * rstd + s0[2], v0[3] * rstd + s0[3]};
            const f32x4 z1 = {v1[0] * rstd + s1[0], v1[1] * rstd + s1[1], v1[2] * rstd + s1[2], v1[3] * rstd + s1[3]};
            uint4 w; w.x = pk2(z0[0], z0[1]); w.y = pk2(z0[2], z0[3]); w.z = pk2(z1[0], z1[1]); w.w = pk2(z1[2], z1[3]);
            *(uint4*)(rowp + bj * HALF) = w;
            vss += ((z0[0] * z0[0] + z0[1] * z0[1]) + (z0[2] * z0[2] + z0[3] * z0[3])) + ((z1[0] * z1[0] + z1[1] * z1[1]) + (z1[2] * z1[2] + z1[3] * z1[3]));
          }
        }
        if (vs_tile) {
          vss += __shfl_xor(vss, 16); vss += __shfl_xor(vss, 32);
          if (fq == 0) ((float*)(p.ws + WS_SSV))[(size_t)row * 8 + (u.pn - 8) * 4 + wc] = vss;
        }
      }
  } else {
    const int cb = cond_of(u.pm * BM);
    const float* gate = (const float*)(p.ws + WS_ADA) + (l * 5 + cb) * 3072 + 2048 + col0;
    f32x4 gv[2][2], gs[2][2], rc[2][2];
    const bool nxt = l < 3;
    const float* ng = p.norm_g + (nxt ? l + 1 : 0) * 1024 + col0;
    const float* nsc = (const float*)(p.ws + WS_ADA) + ((nxt ? l + 1 : 0) * 5 + cb) * 3072 + 1024 + col0;
    const float* cg_ = p.norm_g + l * 1024 + col0;
    const float* csc = (const float*)(p.ws + WS_ADA) + (l * 5 + cb) * 3072 + 1024 + col0;
#pragma unroll
    for (int bj = 0; bj < 2; ++bj)
#pragma unroll
      for (int n = 0; n < 2; ++n) {
        gv[bj][n] = *(const f32x4*)(gate + bj * HALF + 4 * n);
        { const f32x4 a = *(const f32x4*)(ng + bj * HALF + 4 * n), b = *(const f32x4*)(nsc + bj * HALF + 4 * n);
          gs[bj][n] = nxt ? (f32x4){a[0] * (1.f + b[0]), a[1] * (1.f + b[1]), a[2] * (1.f + b[2]), a[3] * (1.f + b[3])} : (f32x4){1.f, 1.f, 1.f, 1.f}; }
        { const f32x4 a = *(const f32x4*)(cg_ + bj * HALF + 4 * n), b = *(const f32x4*)(csc + bj * HALF + 4 * n);
          rc[bj][n] = (f32x4){1.f / (a[0] * (1.f + b[0])), 1.f / (a[1] * (1.f + b[1])), 1.f / (a[2] * (1.f + b[2])), 1.f / (a[3] * (1.f + b[3]))}; }
      }
    bf16_t* Hn = (bf16_t*)(p.ws + WS_H);
    float* SSP = (float*)(p.ws + WS_SSP);
#pragma unroll
    for (int am = 0; am < 4; ++am) {
      const int ai = am >> 1;
      u32x4 hq[2][2];
#pragma unroll
      for (int mm = 0; mm < 2; ++mm)
#pragma unroll
        for (int bj = 0; bj < 2; ++bj) hq[mm][bj] = *(const u32x4*)(Hn + (size_t)(row0 + ai * HALF + ((am & 1) * 2 + mm) * 16) * DM + col0 + bj * HALF);
#pragma unroll
      for (int mm = 0; mm < 2; ++mm) {
        const int m = (am & 1) * 2 + mm;
        const int row = row0 + ai * HALF + m * 16;
        float ss = 0.f;
#pragma unroll
        for (int bj = 0; bj < 2; ++bj) {
          const u32x4 hv = hq[mm][bj];
          f32x4 xv[2], o[2];
          xv[0] = (f32x4){bflo(hv[0]) * rc[bj][0][0], bfhi(hv[0]) * rc[bj][0][1], bflo(hv[1]) * rc[bj][0][2], bfhi(hv[1]) * rc[bj][0][3]};
          xv[1] = (f32x4){bflo(hv[2]) * rc[bj][1][0], bfhi(hv[2]) * rc[bj][1][1], bflo(hv[3]) * rc[bj][1][2], bfhi(hv[3]) * rc[bj][1][3]};
#pragma unroll
          for (int n = 0; n < 2; ++n) {
            const f32x4 a = acc[ai][bj][m][n], g = gv[bj][n];
            o[n] = (f32x4){xv[n][0] + g[0] * a[0], xv[n][1] + g[1] * a[1], xv[n][2] + g[2] * a[2], xv[n][3] + g[3] * a[3]};
            ss += (o[n][0] * o[n][0] + o[n][1] * o[n][1]) + (o[n][2] * o[n][2] + o[n][3] * o[n][3]);
          }
          const f32x4 s0 = gs[bj][0], s1 = gs[bj][1];
          uint4 w; w.x = pk2(o[0][0] * s0[0], o[0][1] * s0[1]); w.y = pk2(o[0][2] * s0[2], o[0][3] * s0[3]);
          w.z = pk2(o[1][0] * s1[0], o[1][1] * s1[1]); w.w = pk2(o[1][2] * s1[2], o[1][3] * s1[3]);
          *(uint4*)(Hn + (size_t)row * DM + col0 + bj * HALF) = w;
        }
        ss += __shfl_xor(ss, 16); ss += __shfl_xor(ss, 32);
        if (fq == 0) SSP[(size_t)row * 16 + u.pn * 4 + wc] = ss;
      }
    }
  }
}

template <int EPI>
__device__ __forceinline__ void gemm_phase(const Params& p, const bf16_t* __restrict__ gA, int lda, const bf16_t* __restrict__ gBt, int nN, int l, int zs, int mode) {
    using namespace pg8;
    constexpr int K = 1024, nt = K / BK;
    PG8_LAS unsigned char* lds = (PG8_LAS unsigned char*)g_smem;
    const int tid = otid(), wid = __builtin_amdgcn_readfirstlane(tid >> 6), lane = tid & 63, wr = wid >> 2, wc = wid & 3, fr = lane & 15, fq = lane >> 4;
    StaticOrder S; S.init(NTOK, nN * BM, ogdim(), obid(), mode);
    unsigned voffA[2], voffB[2];
#pragma unroll
    for (int i = 0; i < 2; ++i) { int R, C; stage_rc(tid * 16 + i * 8192, R, C); const int Rb = (R & ~31) + perm32(R & 31);
        voffA[i] = (unsigned)(R * lda + C) * 2u; voffB[i] = (unsigned)(Rb * K + C) * 2u; }
    const size_t kstep = (size_t)(BK * 2);
    const size_t hstepA = (size_t)HALF * lda * 2, tstepA = 2 * hstepA;
    const size_t hstepB = (size_t)HALF * K * 2, tstepB = 2 * hstepB;
    const unsigned ldsw = (unsigned)wid * 1024u;
    const int aoff = lds_byte(wr * 64 + fr, fq * 8), boff = lds_byte(wc * 32 + fr, fq * 8);
#define PG8_SA(b, h) (((b) * 2 + (h)) * HTB)
#define PG8_SB(b, h) ((4 + (b) * 2 + (h)) * HTB)
#define PG8_STAGE(bufoff, gbase, voff) do { _Pragma("unroll") for (int _i = 0; _i < 2; ++_i) \
        __builtin_amdgcn_global_load_lds((const unsigned*)((const char*)(gbase) + (voff)[_i]), (PG8_LAS unsigned*)(lds + (bufoff) + ldsw + _i * 8192), 16, 0, 0); } while (0)
#define PG8_LDA(dst, b, h) do { _Pragma("unroll") for (int m = 0; m < 4; ++m) _Pragma("unroll") for (int k = 0; k < 2; ++k) dst[m][k] = *(const PG8_LAS bf16x8*)(lds + PG8_SA(b, h) + aoff + m * 2048 + k * 1024); } while (0)
#define PG8_LDB(dst, b, h) do { _Pragma("unroll") for (int n = 0; n < 2; ++n) _Pragma("unroll") for (int k = 0; k < 2; ++k) dst[n][k] = *(const PG8_LAS bf16x8*)(lds + PG8_SB(b, h) + boff + n * 2048 + k * 1024); } while (0)
#define PG8_MMA(ai, bj, At, Bt) do { __builtin_amdgcn_s_setprio(1); _Pragma("unroll") for (int m = 0; m < 4; ++m) _Pragma("unroll") for (int n = 0; n < 2; ++n) _Pragma("unroll") for (int k = 0; k < 2; ++k) \
        acc[ai][bj][m][n] = __builtin_amdgcn_mfma_f32_16x16x32_bf16(Bt[n][k], At[m][k], acc[ai][bj][m][n], 0, 0, 0); __builtin_amdgcn_s_setprio(0); } while (0)
#define PG8_WAIT_V(n) asm volatile("s_waitcnt vmcnt(" #n ")" ::: "memory")
#define PG8_WAIT_L(n) asm volatile("s_waitcnt lgkmcnt(" #n ")" ::: "memory")
#define PG8_BAR __builtin_amdgcn_s_barrier()
#define PG8_SCHED __builtin_amdgcn_sched_barrier(0)
    Unit cur, nxt; int ui = 0;
    if (!S.next(0, cur)) return;
    f32x4 acc[2][2][4][2];
#pragma unroll
    for (int a = 0; a < 2; ++a)
#pragma unroll
        for (int b = 0; b < 2; ++b)
#pragma unroll
            for (int m = 0; m < 4; ++m)
#pragma unroll
                for (int n = 0; n < 2; ++n) acc[a][b][m][n] = (f32x4){0.f, 0.f, 0.f, 0.f};
    bf16x8 At[4][2], B0[2][2], B1[2][2];
    const char* cA = (const char*)gA + (size_t)cur.pm * tstepA; const char* cB = (const char*)gBt + (size_t)cur.pn * tstepB;
    PG8_STAGE(PG8_SB(0, 0), cB, voffB); PG8_STAGE(PG8_SB(0, 1), cB + hstepB, voffB); PG8_STAGE(PG8_SA(0, 0), cA, voffA); PG8_STAGE(PG8_SA(0, 1), cA + hstepA, voffA);
    if (wr == 1) PG8_BAR;
    PG8_WAIT_V(2); PG8_BAR;
    PG8_STAGE(PG8_SB(1, 0), cB + kstep, voffB); PG8_STAGE(PG8_SA(1, 0), cA + kstep, voffA); PG8_STAGE(PG8_SB(1, 1), cB + hstepB + kstep, voffB);
    PG8_WAIT_V(6); PG8_BAR;
    for (;;) {
        const bool has_next = S.next(ui + 1, nxt);
        const char* nA = has_next ? (const char*)gA + (size_t)nxt.pm * tstepA : cA; const char* nB = has_next ? (const char*)gBt + (size_t)nxt.pn * tstepB : cB;
#pragma unroll 1
        for (int t = 0; t < nt; t += 2) {
            const bool last = (t == nt - 2);
            const char* a1 = cA + (size_t)(t + 1) * kstep;
            const char* a2 = last ? nA : cA + (size_t)(t + 2) * kstep; const char* b2 = last ? nB : cB + (size_t)(t + 2) * kstep;
            const char* a3 = a2 + kstep; const char* b3 = b2 + kstep;
            PG8_LDB(B0, 0, 0); PG8_LDB(B1, 0, 1); PG8_SCHED; PG8_LDA(At, 0, 0); PG8_STAGE(PG8_SA(1, 1), a1 + hstepA, voffA);
            PG8_WAIT_V(8); PG8_WAIT_L(0); PG8_BAR; PG8_MMA(0, 0, At, B0); PG8_MMA(0, 1, At, B1); PG8_BAR; PG8_SCHED;
            PG8_LDA(At, 0, 1); PG8_STAGE(PG8_SB(0, 0), b2, voffB); PG8_STAGE(PG8_SB(0, 1), b2 + hstepB, voffB); PG8_STAGE(PG8_SA(0, 0), a2, voffA);
            PG8_WAIT_V(8); PG8_WAIT_L(0); PG8_BAR; PG8_MMA(1, 0, At, B0); PG8_MMA(1, 1, At, B1); PG8_BAR; PG8_SCHED;
            PG8_LDB(B0, 1, 0); PG8_LDB(B1, 1, 1); PG8_SCHED; PG8_LDA(At, 1, 0); PG8_STAGE(PG8_SA(0, 1), a2 + hstepA, voffA);
            PG8_WAIT_V(8); PG8_WAIT_L(0); PG8_BAR; PG8_MMA(0, 0, At, B0); PG8_MMA(0, 1, At, B1); PG8_BAR; PG8_SCHED;
            PG8_LDA(At, 1, 1); PG8_STAGE(PG8_SB(1, 0), b3, voffB); PG8_STAGE(PG8_SB(1, 1), b3 + hstepB, voffB); PG8_STAGE(PG8_SA(1, 0), a3, voffA);
            PG8_WAIT_V(8); PG8_WAIT_L(0); PG8_BAR; PG8_MMA(1, 0, At, B0); PG8_MMA(1, 1, At, B1); PG8_BAR; PG8_SCHED;
        }
        if (wr == 0) PG8_BAR;
        gemm_epilogue<EPI>(p, acc, cur, wr, wc, fr, fq, l, zs);
        if (!has_next) break;
#pragma unroll
        for (int a = 0; a < 2; ++a)
#pragma unroll
            for (int b = 0; b < 2; ++b)
#pragma unroll
                for (int m = 0; m < 4; ++m)
#pragma unroll
                    for (int n = 0; n < 2; ++n) acc[a][b][m][n] = (f32x4){0.f, 0.f, 0.f, 0.f};
        cur = nxt; cA = nA; cB = nB; ++ui;
        if (wr == 1) PG8_BAR;
    }
    PG8_WAIT_V(0);
    PG8_BAR;
#undef PG8_SA
#undef PG8_SB
#undef PG8_STAGE
#undef PG8_LDA
#undef PG8_LDB
#undef PG8_MMA
#undef PG8_WAIT_V
#undef PG8_WAIT_L
#undef PG8_BAR
#undef PG8_SCHED
}

struct GateW { float wf[16], wb[16], biasf, biasb; };
__device__ __forceinline__ void gatew_load(const Params& p, int j, int h, int lane, GateW& g) {
  const float* wgf = p.w_gk + (size_t)((j * 2 + 0) * 16) * 256 + h * 64 + lane;
  const float* wgb = p.w_gk + (size_t)((j * 2 + 1) * 16) * 256 + h * 64 + lane;
#pragma unroll
  for (int r = 0; r < 16; ++r) { g.wf[r] = wgf[r * 256]; g.wb[r] = wgb[r * 256]; }
  g.biasf = p.b_gk[(j * 2 + 0) * 256 + h * 64 + lane]; g.biasb = p.b_gk[(j * 2 + 1) * 256 + h * 64 + lane];
}
__device__ __forceinline__ void gla_cum(const GateW& gw, const float* LR, float* SEG, int lane, int wid,
                                        float (&bf)[16], float (&bb)[16], float& totf, float& totb) {
  const int k = lane, seg = wid;
  const float (&wf)[16] = gw.wf; const float (&wb)[16] = gw.wb;
  const float biasf = gw.biasf, biasb = gw.biasb;
  float sf = 0.f, sb = 0.f;
#pragma unroll
  for (int i = 0; i < 16; ++i) {
    const f32x4* lr = (const f32x4*)(LR + (seg * 16 + i) * 32);
    float gf = biasf, gb = biasb;
#pragma unroll
    for (int r4 = 0; r4 < 4; ++r4) {
      f32x4 a = lr[r4], b = lr[4 + r4];
      gf += a[0] * wf[r4 * 4 + 0] + a[1] * wf[r4 * 4 + 1] + a[2] * wf[r4 * 4 + 2] + a[3] * wf[r4 * 4 + 3];
      gb += b[0] * wb[r4 * 4 + 0] + b[1] * wb[r4 * 4 + 1] + b[2] * wb[r4 * 4 + 2] + b[3] * wb[r4 * 4 + 3];
    }
    gf = logsig(gf) * (1.f / 16.f); gb = logsig(gb) * (1.f / 16.f);
    sf += gf; bf[i] = sf;
    bb[i] = gb; sb += gb;
  }
  SEG[(0 * 8 + seg) * 64 + k] = sf; SEG[(1 * 8 + seg) * 64 + k] = sb;
  __syncthreads();
  float offf = 0.f, offb = 0.f; totf = 0.f; totb = 0.f;
#pragma unroll
  for (int s = 0; s < 8; ++s) {
    float a = SEG[s * 64 + k], b = SEG[(8 + s) * 64 + k];
    totf += a; totb += b;
    if (s < seg) offf += a;
    if (s > seg) offb += b;
  }
#pragma unroll
  for (int i = 0; i < 16; ++i) bf[i] += offf;
  float run = offb;
#pragma unroll
  for (int i = 15; i >= 0; --i) { run += bb[i]; bb[i] = run; }
}

__device__ __forceinline__ uint4 lr_load(const bf16_t* Z, int base, int C, bool colm, int tid) {
  const int pos = tid >> 2, part = tid & 3;
  const int tok = tok_of(base, C * 128 + pos, colm);
  return *(const uint4*)(Z + (size_t)tok * ZS_E + 3072 + part * 8);
}
__device__ __forceinline__ void lr_store(const uint4 v, float* LR, int tid) {
  const int pos = tid >> 2, part = tid & 3;
  float* d = LR + pos * 32 + part * 8;
  d[0] = bflo(v.x); d[1] = bfhi(v.x); d[2] = bflo(v.y); d[3] = bfhi(v.y); d[4] = bflo(v.z); d[5] = bfhi(v.z); d[6] = bflo(v.w); d[7] = bfhi(v.w);
}
__device__ __forceinline__ void fill_T128(const bf16_t* Z, int zs, int base, int C, bool colm, int col0, char* DST, int ldb, int tid) {
  uint4 v[4];
#pragma unroll
  for (int ii = 0; ii < 4; ++ii) {
    const int id = tid + ii * 512, pos = (id & 15) | (((id >> 6) & 7) << 4), vc = ((id >> 4) & 3) | ((id >> 9) << 2);
    const int tok = tok_of(base, C * 128 + pos, colm);
    v[ii] = *(const uint4*)(Z + (size_t)tok * zs + col0 + vc * 8);
  }
  SCHED_FENCE();
#pragma unroll
  for (int ii = 0; ii < 4; ++ii) {
    const int id = tid + ii * 512, pos = (id & 15) | (((id >> 6) & 7) << 4), vc = ((id >> 4) & 3) | ((id >> 9) << 2);
#pragma unroll
    for (int e = 0; e < 8; ++e) *(bf16_t*)(DST + slot32(vc * 8 + e) * ldb + pos * 2) = bfel(v[ii], e);
  }
}

__device__ __forceinline__ void m1_gla_item(const Params& p, int l, int item, const GateW& gw) {
  char* smem = g_smem;
  const int tid = otid(), lane = tid & 63, wid = tid >> 6, fr = lane & 15, fq = lane >> 4;
  const int cidx = item >> 2, h = item & 3, j = l >> 1;
  int base, T, C; chunk_info(cidx, base, T, C);
  const bool colm = (l >= 2) && (T == 4096);
  const bf16_t* Z = (const bf16_t*)(p.ws + WS_Z);
  float* LR = (float*)smem; float* SEG = (float*)(smem + 16384); char* KT = smem + 20480; char* VT = smem + 55296;
  bf16_t* ST = (bf16_t*)(p.ws + WS_ST); float* DEC = (float*)(p.ws + WS_DEC);
  char* KQ = smem + 90112;
  {
    const uint4 lrv = lr_load(Z, base, C, colm, tid);
    u32x4 kq[2];
#pragma unroll
    for (int ii = 0; ii < 2; ++ii) {
      const int id = tid + ii * 512, pos = id >> 3, c = id & 7;
      const int tok = tok_of(base, C * 128 + pos, colm);
      kq[ii] = *(const u32x4*)(Z + (size_t)tok * ZS_E + 256 + h * 64 + c * 8);
    }
    SCHED_FENCE();
    lr_store(lrv, LR, tid);
#pragma unroll
    for (int ii = 0; ii < 2; ++ii) { const int id = tid + ii * 512, pos = id >> 3, c = id & 7; *(u32x4*)(KQ + pos * 144 + c * 16) = kq[ii]; }
  }
  fill_T128(Z, ZS_E, base, C, colm, 512 + h * 128, VT, 272, tid);
  __syncthreads();
  float bf[16], bb[16], totf, totb;
  gla_cum(gw, LR, SEG, lane, wid, bf, bb, totf, totb);
  {
    const int k = lane, seg = wid;
#pragma unroll
    for (int i = 0; i < 16; ++i) {
      const int pos = seg * 16 + i;
      const float kv = bf2f(*(const bf16_t*)(KQ + pos * 144 + k * 2));
      *(bf16_t*)(KT + k * 272 + pos * 2) = f2bf(kv * __expf(totf - bf[i]));
      *(bf16_t*)(KT + 17408 + k * 272 + pos * 2) = f2bf(kv * __expf(totb - bb[i]));
    }
    if (seg == 0) {
      DEC[((cidx * 4 + h) * 2 + 0) * 64 + k] = __expf(totf);
      DEC[((cidx * 4 + h) * 2 + 1) * 64 + k] = __expf(totb);
    }
  }
  __syncthreads();
  {
    const int dir = wid >> 2, kblk = wid & 3;
    f32x4 acc[8];
#pragma unroll
    for (int n = 0; n < 8; ++n) acc[n] = (f32x4){0.f, 0.f, 0.f, 0.f};
#pragma unroll
    for (int kb = 0; kb < 4; ++kb) {
      bf16x8 a = *(const bf16x8*)(KT + dir * 17408 + (kblk * 16 + fr) * 272 + (kb * 32 + fq * 8) * 2);
#pragma unroll
      for (int n = 0; n < 8; ++n) {
        bf16x8 b = *(const bf16x8*)(VT + (n * 16 + fr) * 272 + (kb * 32 + fq * 8) * 2);
        acc[n] = MFMA16(b, a, acc[n]);
      }
    }
    bf16_t* dst = ST + (size_t)((cidx * 4 + h) * 2 + dir) * 8192 + (kblk * 16 + fr) * 128 + fq * 8;
#pragma unroll
    for (int t = 0; t < 4; ++t) {
      uint4 o; o.x = pk2(acc[2 * t][0], acc[2 * t][1]); o.y = pk2(acc[2 * t][2], acc[2 * t][3]); o.z = pk2(acc[2 * t + 1][0], acc[2 * t + 1][1]); o.w = pk2(acc[2 * t + 1][2], acc[2 * t + 1][3]);
      *(uint4*)(dst + t * 32) = o;
    }
  }
  __syncthreads();
}

__device__ void sgu_item(const Params& p, int l, int item) {
  char* smem = g_smem;
  const int tid = otid(), lane = tid & 63, wid = tid >> 6, fr = lane & 15, fq = lane >> 4;
  const int cidx = item >> 2, hb = item & 3, j = l >> 1;
  int base, T, C; chunk_info(cidx, base, T, C);
  const bool colm = (l >= 2) && (T == 4096);
  bf16_t* Z = (bf16_t*)(p.ws + WS_Z);
  char* WS = smem; char* VNT = smem + 34816; float* RSTD = (float*)(smem + 69632);
  {
    const bf16_t* w = (const bf16_t*)(p.ws + WS_WSB) + (size_t)(j * 4 + hb) * 16384;
    const float* SSV = (const float*)(p.ws + WS_SSV);
    u32x4 wq[4]; f32x4 s0, s1;
    const int pos = tid & 127;
    {
      const int tok = tok_of(base, C * 128 + pos, colm);
      s0 = *(const f32x4*)(SSV + (size_t)tok * 8); s1 = *(const f32x4*)(SSV + (size_t)tok * 8 + 4);
    }
#pragma unroll
    for (int ii = 0; ii < 4; ++ii) { const int id = tid + ii * 512, i = id >> 4, cc = id & 15; wq[ii] = *(const u32x4*)(w + i * 128 + cc * 8); }
    SCHED_FENCE();
    if (tid < 128) RSTD[pos] = rsqrtf((((s0[0] + s0[1]) + (s0[2] + s0[3])) + ((s1[0] + s1[1]) + (s1[2] + s1[3]))) * (1.f / 512.f) + EPS);
#pragma unroll
    for (int ii = 0; ii < 4; ++ii) { const int id = tid + ii * 512, i = id >> 4, cc = id & 15; *(u32x4*)(WS + i * 272 + cc * 16) = wq[ii]; }
  }
  __syncthreads();
  {
    uint4 vq[4];
#pragma unroll
    for (int ii = 0; ii < 4; ++ii) {
      const int id = tid + ii * 512, pos = (id & 15) | (((id >> 6) & 7) << 4), vc = ((id >> 4) & 3) | ((id >> 9) << 2);
      const int tok = tok_of(base, C * 128 + pos, colm);
      vq[ii] = *(const uint4*)(Z + (size_t)tok * ZS_E + 2048 + hb * 128 + vc * 8);
    }
    SCHED_FENCE();
#pragma unroll
    for (int ii = 0; ii < 4; ++ii) {
      const int id = tid + ii * 512, pos = (id & 15) | (((id >> 6) & 7) << 4), vc = ((id >> 4) & 3) | ((id >> 9) << 2);
      const uint4 v = vq[ii];
      const float rs = RSTD[pos];
      const float* g = p.sgu_norm_g + j * 512 + hb * 128 + vc * 8;
#pragma unroll
      for (int e = 0; e < 8; ++e) *(bf16_t*)(VNT + slot32(vc * 8 + e) * 272 + pos * 2) = f2bf(bf2f(bfel(v, e)) * rs * g[e]);
    }
  }
  __syncthreads();
  {
    const int i0 = wid * 16;
    f32x4 acc[8];
#pragma unroll
    for (int n = 0; n < 8; ++n) acc[n] = (f32x4){0.f, 0.f, 0.f, 0.f};
#pragma unroll
    for (int kb = 0; kb < 4; ++kb) {
      bf16x8 a = *(const bf16x8*)(WS + (i0 + fr) * 272 + (kb * 32 + fq * 8) * 2);
#pragma unroll
      for (int n = 0; n < 8; ++n) {
        bf16x8 b = *(const bf16x8*)(VNT + (n * 16 + fr) * 272 + (kb * 32 + fq * 8) * 2);
        acc[n] = MFMA16(b, a, acc[n]);
      }
    }
    const int i = i0 + fr;
    const int tok = tok_of(base, C * 128 + i, colm);
    const float bs = p.b_s[(j * 4 + hb) * 128 + i];
    bf16_t* zr = Z + (size_t)tok * ZS_E;
    uint4 uq[4], gq[4];
#pragma unroll
    for (int t = 0; t < 4; ++t) { const int d = hb * 128 + t * 32 + fq * 8; uq[t] = *(const uint4*)(zr + 1024 + d); gq[t] = *(const uint4*)(zr + 2560 + d); }
    SCHED_FENCE();
#pragma unroll
    for (int t = 0; t < 4; ++t) {
      const int d = hb * 128 + t * 32 + fq * 8;
      float o[8];
#pragma unroll
      for (int e = 0; e < 8; ++e) o[e] = bf2f(bfel(uq[t], e)) * (acc[2 * t + (e >> 2)][e & 3] + bs) * silu_f(bf2f(bfel(gq[t], e)));
      uint4 ov; ov.x = pk2(o[0], o[1]); ov.y = pk2(o[2], o[3]); ov.z = pk2(o[4], o[5]); ov.w = pk2(o[6], o[7]);
      *(uint4*)(zr + 1024 + d) = ov;
    }
  }
  __syncthreads();
}

template <int NCHK, int BATCH, int NI>
__device__ __forceinline__ void scan_multi(bf16_t* ST, const float* DEC, const int (&cidx0)[NI], const int (&h)[NI], const int (&dir)[NI], const bool (&ok)[NI], const int (&e)[NI], float (&S)[NI]) {
#pragma unroll 1
  for (int s0 = 0; s0 < NCHK; s0 += BATCH) {
    float hv[NI][BATCH], dv[NI][BATCH];
#pragma unroll
    for (int q = 0; q < NI; ++q)
#pragma unroll
      for (int i = 0; i < BATCH; ++i) {
        const int step = s0 + i, Cc = dir[q] == 0 ? step : NCHK - 1 - step;
        const size_t idx = (size_t)(((cidx0[q] + Cc) * 4 + h[q]) * 2 + dir[q]);
        hv[q][i] = bf2f(ST[idx * 8192 + e[q]]); dv[q][i] = DEC[idx * 64 + (e[q] >> 7)];
      }
    SCHED_FENCE();
#pragma unroll
    for (int q = 0; q < NI; ++q)
#pragma unroll
      for (int i = 0; i < BATCH; ++i) {
        const int step = s0 + i, Cc = dir[q] == 0 ? step : NCHK - 1 - step;
        const size_t idx = (size_t)(((cidx0[q] + Cc) * 4 + h[q]) * 2 + dir[q]);
        if (ok[q]) ST[idx * 8192 + e[q]] = f2bf(S[q]);
        S[q] = dv[q][i] * S[q] + hv[q][i];
      }
  }
}
__device__ void m2_phase(const Params& p, int l) {
  const int tid = otid(), j = l >> 1, G = ogdim(), b0 = obid();
  bf16_t* ST = (bf16_t*)(p.ws + WS_ST); const float* DEC = (const float*)(p.ws + WS_DEC);
  for (int item = b0; item < 512; item += 2 * G) {
    int c0[2], hh[2], dd[2], ee[2]; bool ok[2]; float S[2];
#pragma unroll
    for (int q = 0; q < 2; ++q) {
      const int it = item + q * G; ok[q] = it < 512;
      const int itc = ok[q] ? it : item;
      const int chain = itc >> 4, slab = itc & 15, b = chain >> 3;
      hh[q] = (chain >> 1) & 3; dd[q] = chain & 1; ee[q] = slab * 512 + tid; c0[q] = 64 + b * 32;
      S[q] = p.state_gla[((size_t)((b * 2 + j) * 2 + dd[q]) * 4 + hh[q]) * 8192 + ee[q]];
    }
    scan_multi<32, 8, 2>(ST, DEC, c0, hh, dd, ok, ee, S);
  }
  for (int item = b0; item < 4096; item += 4 * G) {
    int c0[4], hh[4], dd[4], ee[4], bb[4]; bool ok[4]; float S[4];
#pragma unroll
    for (int q = 0; q < 4; ++q) {
      const int it = item + q * G; ok[q] = it < 4096;
      const int itc = ok[q] ? it : item;
      const int chain = itc >> 4, slab = itc & 15; bb[q] = chain >> 3;
      hh[q] = (chain >> 1) & 3; dd[q] = chain & 1; ee[q] = slab * 512 + tid; c0[q] = bb[q] * 2;
      S[q] = 0.f;
    }
    scan_multi<2, 2, 4>(ST, DEC, c0, hh, dd, ok, ee, S);
#pragma unroll
    for (int q = 0; q < 4; ++q)
      if (ok[q]) p.out[(size_t)NTOK * DM + ((size_t)((bb[q] * 2 + j) * 2 + dd[q]) * 4 + hh[q]) * 8192 + ee[q]] = S[q];
  }
}

__device__ __forceinline__ void m3_gla_item(const Params& p, int l, int item, const GateW& gw) {
  char* smem = g_smem;
  const int tid = otid(), lane = tid & 63, wid = tid >> 6, fr = lane & 15, fq = lane >> 4;
  const int cidx = item >> 2, h = item & 3, j = l >> 1;
  int base, T, C; chunk_info(cidx, base, T, C);
  const bool colm = (l >= 2) && (T == 4096);
  bf16_t* Z = (bf16_t*)(p.ws + WS_Z);
  char* AT = smem; char* VST = smem + 67584; char* KPf = smem + 67584; char* KPb = smem + 67584 + 18432;
  float* LR = (float*)(smem + 135168); float* SEG = (float*)(smem + 135168 + 16384);
  const bf16_t* ST = (const bf16_t*)(p.ws + WS_ST);
  {
    const uint4 lrv = lr_load(Z, base, C, colm, tid);
    u32x4 qk[4];
#pragma unroll
    for (int ii = 0; ii < 4; ++ii) {
      const int id = tid + ii * 512, pos = id >> 4, c = id & 15;
      const int tok = tok_of(base, C * 128 + pos, colm);
      qk[ii] = *(const u32x4*)(Z + (size_t)tok * ZS_E + (c < 8 ? h * 64 + c * 8 : 256 + h * 64 + (c - 8) * 8));
    }
    SCHED_FENCE();
    lr_store(lrv, LR, tid);
#pragma unroll
    for (int ii = 0; ii < 4; ++ii) { const int id = tid + ii * 512, pos = id >> 4, c = id & 15; *(u32x4*)(AT + pos * 528 + c * 16) = qk[ii]; }
  }
  __syncthreads();
  {
    float bf[16], bb[16], totf, totb;
    gla_cum(gw, LR, SEG, lane, wid, bf, bb, totf, totb);
    const int k = lane, seg = wid;
#pragma unroll
    for (int i = 0; i < 16; ++i) {
      const int pos = seg * 16 + i;
      const float q = bf2f(*(const bf16_t*)(AT + pos * 528 + k * 2)) * 0.125f;
      const float kk = bf2f(*(const bf16_t*)(AT + pos * 528 + 128 + k * 2));
      *(bf16_t*)(AT + pos * 528 + (128 + k) * 2) = f2bf(q * __expf(bf[i]));
      *(bf16_t*)(AT + pos * 528 + (192 + k) * 2) = f2bf(q * __expf(bb[i]));
      *(bf16_t*)(KPf + pos * 144 + k * 2) = f2bf(kk * __expf(-bf[i]));
      *(bf16_t*)(KPb + pos * 144 + k * 2) = f2bf(kk * __expf(-bb[i]));
    }
  }
  __syncthreads();
  const int i0 = wid * 16;
  {
    f32x4 pf[8], pb[8];
#pragma unroll
    for (int n = 0; n < 8; ++n) { pf[n] = (f32x4){0.f, 0.f, 0.f, 0.f}; pb[n] = (f32x4){0.f, 0.f, 0.f, 0.f}; }
#pragma unroll
    for (int kb = 0; kb < 2; ++kb) {
      bf16x8 aqf = *(const bf16x8*)(AT + (i0 + fr) * 528 + (128 + kb * 32 + fq * 8) * 2);
      bf16x8 aqb = *(const bf16x8*)(AT + (i0 + fr) * 528 + (192 + kb * 32 + fq * 8) * 2);
#pragma unroll
      for (int n = 0; n < 8; ++n) {
        bf16x8 bkf = *(const bf16x8*)(KPf + (n * 16 + fr) * 144 + (kb * 32 + fq * 8) * 2);
        bf16x8 bkb = *(const bf16x8*)(KPb + (n * 16 + fr) * 144 + (kb * 32 + fq * 8) * 2);
        pf[n] = MFMA16(bkf, aqf, pf[n]);
        pb[n] = MFMA16(bkb, aqb, pb[n]);
      }
    }
    const int i = i0 + fr;
#pragma unroll
    for (int n = 0; n < 8; ++n) {
      float a[4];
#pragma unroll
      for (int r = 0; r < 4; ++r) { const int jj = n * 16 + fq * 4 + r; a[r] = (jj <= i ? pf[n][r] : 0.f) + (jj >= i ? pb[n][r] : 0.f); }
      uint2 o; o.x = pk2(a[0], a[1]); o.y = pk2(a[2], a[3]);
      *(uint2*)(AT + i * 528 + (n * 16 + fq * 4) * 2) = o;
    }
  }
  __syncthreads();
  fill_T128(Z, ZS_E, base, C, colm, 512 + h * 128, VST, 528, tid);
  {
    u32x2 sq[2][4];
#pragma unroll
    for (int dir = 0; dir < 2; ++dir) {
      const bf16_t* s = ST + (size_t)((cidx * 4 + h) * 2 + dir) * 8192;
#pragma unroll
      for (int ii = 0; ii < 4; ++ii) { const int id = tid + ii * 512, k = id & 63, v4 = id >> 6; sq[dir][ii] = *(const u32x2*)(s + k * 128 + v4 * 4); }
    }
    SCHED_FENCE();
#pragma unroll
    for (int dir = 0; dir < 2; ++dir)
#pragma unroll
      for (int ii = 0; ii < 4; ++ii) {
        const int id = tid + ii * 512, k = id & 63, v4 = id >> 6;
        const unsigned w0 = sq[dir][ii][0], w1 = sq[dir][ii][1];
        char* d0 = VST + slot32(v4 * 4) * 528 + (128 + dir * 64 + k) * 2;
        *(bf16_t*)(d0) = (bf16_t)(w0 & 0xffffu); *(bf16_t*)(d0 + 528) = (bf16_t)(w0 >> 16);
        *(bf16_t*)(d0 + 1056) = (bf16_t)(w1 & 0xffffu); *(bf16_t*)(d0 + 1584) = (bf16_t)(w1 >> 16);
      }
  }
  __syncthreads();
  {
    f32x4 o[8];
#pragma unroll
    for (int n = 0; n < 8; ++n) o[n] = (f32x4){0.f, 0.f, 0.f, 0.f};
#pragma unroll
    for (int kb = 0; kb < 8; ++kb) {
      bf16x8 a = *(const bf16x8*)(AT + (i0 + fr) * 528 + (kb * 32 + fq * 8) * 2);
#pragma unroll
      for (int n = 0; n < 8; ++n) {
        bf16x8 b = *(const bf16x8*)(VST + (n * 16 + fr) * 528 + (kb * 32 + fq * 8) * 2);
        o[n] = MFMA16(b, a, o[n]);
      }
    }
    float ss = 0.f;
#pragma unroll
    for (int n = 0; n < 8; ++n) ss += o[n][0] * o[n][0] + o[n][1] * o[n][1] + o[n][2] * o[n][2] + o[n][3] * o[n][3];
    ss += __shfl_xor(ss, 16); ss += __shfl_xor(ss, 32);
    const float rstd = rsqrtf(ss * (1.f / 128.f) + EPS);
    const int tok = tok_of(base, C * 128 + i0 + fr, colm);
    bf16_t* zr = Z + (size_t)tok * ZS_E;
    uint4 gaq[4]; f32x4 gq[8];
#pragma unroll
    for (int t = 0; t < 4; ++t) {
      gaq[t] = *(const uint4*)(zr + 1536 + h * 128 + t * 32 + fq * 8);
      gq[2 * t] = *(const f32x4*)(p.gla_norm_g + j * 128 + t * 32 + fq * 8); gq[2 * t + 1] = *(const f32x4*)(p.gla_norm_g + j * 128 + t * 32 + fq * 8 + 4);
    }
    SCHED_FENCE();
#pragma unroll
    for (int t = 0; t < 4; ++t) {
      float r[8];
#pragma unroll
      for (int e = 0; e < 8; ++e) r[e] = o[2 * t + (e >> 2)][e & 3] * rstd * gq[2 * t + (e >> 2)][e & 3] * silu_f(bf2f(bfel(gaq[t], e)));
      uint4 ov; ov.x = pk2(r[0], r[1]); ov.y = pk2(r[2], r[3]); ov.z = pk2(r[4], r[5]); ov.w = pk2(r[6], r[7]);
      *(uint4*)(zr + 512 + h * 128 + t * 32 + fq * 8) = ov;
    }
  }
  __syncthreads();
}

__device__ void odd_item(const Params& p, int l, int item) {
  char* smem = g_smem;
  const int tid = otid(), lane = tid & 63, wid = tid >> 6, fr = lane & 15, fq = lane >> 4;
  const int cidx = item >> 2, g = item & 3, j = l >> 1;
  int base, T, C; chunk_info(cidx, base, T, C);
  const bool colm = (l >= 2) && (T == 4096);
  bf16_t* Z = (bf16_t*)(p.ws + WS_Z);
  char* XC = smem; char* PL = smem + 39168; char* WP = smem + 73984;
  const int p0 = C * 128;
  const bool conv_first = ((obid() >> 3) & 1) != 0;
#pragma unroll 1
  for (int pass = 0; pass < 2; ++pass) {
    if ((pass == 0) != conv_first) {
      {
        const bf16_t* w = (const bf16_t*)(p.ws + WS_WPT) + (size_t)(j * 4 + g) * 16384;
        u32x4 xv[5], wv[4];
    #pragma unroll
        for (int ii = 0; ii < 5; ++ii) {
          const int id = min(tid + ii * 512, 144 * 16 - 1), r = id >> 4, cc = id & 15, pos = p0 - 8 + r;
          const int pcl = min(max(pos, 0), T - 1);
          xv[ii] = *(const u32x4*)(Z + (size_t)tok_of(base, pcl, colm) * ZS_O + g * 128 + cc * 8);
        }
    #pragma unroll
        for (int ii = 0; ii < 4; ++ii) { const int id = tid + ii * 512, d = id >> 4, cc = id & 15; wv[ii] = *(const u32x4*)(w + d * 128 + cc * 8); }
        SCHED_FENCE();
    #pragma unroll
        for (int ii = 0; ii < 5; ++ii) {
          const int id = min(tid + ii * 512, 144 * 16 - 1), r = id >> 4, cc = id & 15;
          *(u32x4*)(XC + r * 272 + cc * 16) = xv[ii];
        }
    #pragma unroll
        for (int ii = 0; ii < 4; ++ii) { const int id = tid + ii * 512, d = id >> 4, cc = id & 15; *(u32x4*)(WP + slot32(d) * 272 + cc * 16) = wv[ii]; }
      }
      __syncthreads();
      {
        const int hw = 1 << g;
    #pragma unroll
        for (int ii = 0; ii < 4; ++ii) {
          const int id = tid + ii * 512, t = id >> 4, cc = id & 15, pos = p0 + t;
          const int lo = max(pos - hw, 0), hi = min(pos + hw, T);
          float s[8];
    #pragma unroll
          for (int e = 0; e < 8; ++e) s[e] = 0.f;
          for (int pp = lo; pp < hi; ++pp) {
            uint4 v = *(const uint4*)(XC + (pp - p0 + 8) * 272 + cc * 16);
            s[0] += bflo(v.x); s[1] += bfhi(v.x); s[2] += bflo(v.y); s[3] += bfhi(v.y); s[4] += bflo(v.z); s[5] += bfhi(v.z); s[6] += bflo(v.w); s[7] += bfhi(v.w);
          }
          const float inv = 1.f / (float)(hi - lo);
          uint4 cv = *(const uint4*)(XC + (t + 8) * 272 + cc * 16);
          uint4 o;
          o.x = pk2(s[0] * inv - bflo(cv.x), s[1] * inv - bfhi(cv.x));
          o.y = pk2(s[2] * inv - bflo(cv.y), s[3] * inv - bfhi(cv.y));
          o.z = pk2(s[4] * inv - bflo(cv.z), s[5] * inv - bfhi(cv.z));
          o.w = pk2(s[6] * inv - bflo(cv.w), s[7] * inv - bfhi(cv.w));
          *(uint4*)(PL + t * 272 + cc * 16) = o;
        }
      }
      __syncthreads();
      {
        const int i0 = wid * 16;
        f32x4 acc[8];
    #pragma unroll
        for (int n = 0; n < 8; ++n) acc[n] = (f32x4){0.f, 0.f, 0.f, 0.f};
    #pragma unroll
        for (int kb = 0; kb < 4; ++kb) {
          bf16x8 a = *(const bf16x8*)(PL + (i0 + fr) * 272 + (kb * 32 + fq * 8) * 2);
    #pragma unroll
          for (int n = 0; n < 8; ++n) {
            bf16x8 b = *(const bf16x8*)(WP + (n * 16 + fr) * 272 + (kb * 32 + fq * 8) * 2);
            acc[n] = MFMA16(b, a, acc[n]);
          }
        }
        const int tok = tok_of(base, p0 + i0 + fr, colm);
        bf16_t* zr = Z + (size_t)tok * ZS_O;
        uint4 gcq[4]; f32x4 psq[8];
#pragma unroll
        for (int t = 0; t < 4; ++t) {
          const int d = g * 128 + t * 32 + fq * 8;
          gcq[t] = *(const uint4*)(zr + 512 + d);
          psq[2 * t] = *(const f32x4*)(p.pool_scale + j * 512 + d); psq[2 * t + 1] = *(const f32x4*)(p.pool_scale + j * 512 + d + 4);
        }
        SCHED_FENCE();
#pragma unroll
        for (int t = 0; t < 4; ++t) {
          const int d = g * 128 + t * 32 + fq * 8;
          float r[8];
#pragma unroll
          for (int e = 0; e < 8; ++e) r[e] = acc[2 * t + (e >> 2)][e & 3] * psq[2 * t + (e >> 2)][e & 3] * silu_f(bf2f(bfel(gcq[t], e)));
          uint4 o; o.x = pk2(r[0], r[1]); o.y = pk2(r[2], r[3]); o.z = pk2(r[4], r[5]); o.w = pk2(r[6], r[7]);
          *(uint4*)(zr + 512 + d) = o;
        }
      }
    } else {
      {
        const int cc = tid & 15, ch = g * 128 + cc * 8;
        float w0[8], w1[8], w2[8];
        {
          const float* wp = p.w_conv + (size_t)(j * 3) * 512 + ch;
    #pragma unroll
          for (int e = 0; e < 8; ++e) { w0[e] = wp[e]; w1[e] = wp[512 + e]; w2[e] = wp[1024 + e]; }
        }
    #pragma unroll 1
        for (int pass = 0; pass < 2; ++pass) {
          uint4 xdq[2][3], cdq[2][3], bdq[2], gdq[2];
    #pragma unroll
          for (int uu = 0; uu < 2; ++uu) {
            const int t = (tid >> 4) + (pass * 2 + uu) * 32, pos = p0 + t;
    #pragma unroll
            for (int dd = 0; dd < 3; ++dd) {
              const int pp = pos - 1 + dd;
              const bf16_t* zr = Z + (size_t)tok_of(base, min(max(pp, 0), T - 1), colm) * ZS_O;
              xdq[uu][dd] = *(const uint4*)(zr + 1536 + ch); cdq[uu][dd] = *(const uint4*)(zr + 2048 + ch);
            }
            const bf16_t* zr = Z + (size_t)tok_of(base, pos, colm) * ZS_O;
            bdq[uu] = *(const uint4*)(zr + 1024 + ch); gdq[uu] = *(const uint4*)(zr + 2560 + ch);
          }
    #pragma unroll
          for (int uu = 0; uu < 2; ++uu) {
            const int t = (tid >> 4) + (pass * 2 + uu) * 32, pos = p0 + t;
            float o[8];
    #pragma unroll
            for (int e = 0; e < 8; ++e) {
              float y = 0.f;
    #pragma unroll
              for (int dd = 0; dd < 3; ++dd) {
                const int pp = pos - 1 + dd;
                const float mk = (pp >= 0 && pp < T) ? 1.f : 0.f;
                const float uv = mk * bf2f(bfel(xdq[uu][dd], e)) * bf2f(bfel(cdq[uu][dd], e));
                y += uv * (dd == 0 ? w0[e] : dd == 1 ? w1[e] : w2[e]);
              }
              o[e] = bf2f(bfel(bdq[uu], e)) * y * silu_f(bf2f(bfel(gdq[uu], e)));
            }
            uint4 ov; ov.x = pk2(o[0], o[1]); ov.y = pk2(o[2], o[3]); ov.z = pk2(o[4], o[5]); ov.w = pk2(o[6], o[7]);
            *(uint4*)(Z + (size_t)tok_of(base, pos, colm) * ZS_O + 1024 + ch) = ov;
          }
        }
      }
    }
  }
  __syncthreads();
}

__device__ __forceinline__ void run_phase(const Params& p, int ph, int l) {
  if (ph == 2 || ph == 6 || ph >= 9) {
    int g2mode = -1, g1mode = -1, l1 = l;
    if (ph == 2) g1mode = 0;
    else if (ph == 6) g2mode = 0;
    else if (ph == 9) g2mode = 1;
    else if (ph == 10) { if (obid() < 128) g2mode = 2; else { g1mode = 3; l1 = l + 1; } }
    else { g1mode = 4; l1 = l + 1; }
    if (g2mode >= 0) {
      const bool ev = (l & 1) == 0;
      gemm_phase<1>(p, (const bf16_t*)(p.ws + WS_Z) + 512, ev ? ZS_E : ZS_O, (const bf16_t*)(p.ws + WS_WOUT) + (size_t)l * 1024 * 1024, 4, l, 0, g2mode);
    }
    if (g1mode >= 0) {
      const bool ev = (l1 & 1) == 0; const int j1 = l1 >> 1;
      gemm_phase<0>(p, (const bf16_t*)(p.ws + WS_H), DM,
                    ev ? (const bf16_t*)(p.ws + WS_WINE) + (size_t)j1 * NPAD_E * 1024 : (const bf16_t*)(p.ws + WS_WINO) + (size_t)j1 * 3072 * 1024,
                    ev ? 13 : 12, l1, ev ? ZS_E : ZS_O, g1mode);
    }
    return;
  }
  const bool even = (l & 1) == 0;
  const int j = l >> 1;
  switch (ph) {
    case 0: prep_phase(p); break;
    case 1: if (l == 4) final_norm_phase(p); else norm_phase(p, l); break;
    case 3:
    case 5:
      if (even) {
        GateW gw; int hl = -1;
        const int G = ogdim(), b0 = obid();
        const int nG = (768 - b0 + G - 1) / G;
        const int cut = ((((b0 >> 3) & 3) * nG) + 1) / 3;
#pragma unroll 1
        for (int sec = 0; sec < 3; ++sec) {
          if (sec == 1) {
            int k = 0;
            for (int item = b0; item < 768; item += G, ++k) { if (((k % 3) == 2) == (ph == 5)) sgu_item(p, l, item); }
          } else {
            const int lo = sec == 0 ? 0 : cut, hi = sec == 0 ? cut : nG;
            for (int i = lo; i < hi; ++i) {
              const int item = b0 + i * G;
              if ((item & 3) != hl) { hl = item & 3; gatew_load(p, j, hl, otid() & 63, gw); }
              if (ph == 3) m1_gla_item(p, l, item, gw); else m3_gla_item(p, l, item, gw);
            }
          }
        }
      } else {
        for (int item = obid(); item < 768; item += ogdim()) odd_item(p, l, item);
      }
      break;
    case 4: m2_phase(p, l); break;
  }
}

template <int PH> __global__ void __launch_bounds__(512, 2) k_phase(Params p, int l) { run_phase(p, PH, l); }

#define XB_TMO      128
#define XB_XCNT(j)  (256  + 64 * (j))
#define XB_XSUB(j)  (1280 + 64 * (j))
#define XB_XGEN(j)  (2304 + 64 * (j))
#define XB_TOP      3328
#define XB_TOPGEN   3392
#define XCD_BAR_WORDS 3456
#define XB_SPIN_CAP (1u << 18)
#define LAS __attribute__((address_space(3)))
__device__ __forceinline__ unsigned xb_ld(unsigned* p)              { return __hip_atomic_load(p, __ATOMIC_RELAXED, __HIP_MEMORY_SCOPE_AGENT); }
__device__ __forceinline__ unsigned xb_add(unsigned* p, unsigned v) { return __hip_atomic_fetch_add(p, v, __ATOMIC_RELAXED, __HIP_MEMORY_SCOPE_AGENT); }
__device__ __forceinline__ unsigned xb_xcc_id() { return (unsigned)__builtin_amdgcn_s_getreg((3 << 11) | 20) & 0xFu; }
#define XB_SPIN(cond, bar) do { unsigned _sp = 0; while (cond) { __builtin_amdgcn_s_sleep(1); \
    if ((++_sp & 255u) == 0u) { if (xb_ld(&(bar)[XB_TMO])) break; if (_sp > XB_SPIN_CAP) { atomicAdd(&(bar)[XB_TMO], 1u); break; } } } } while (0)
struct XcdBarrier { unsigned* bar; unsigned x; volatile LAS unsigned* st; };
__device__ __forceinline__ XcdBarrier xcd_barrier_post(unsigned* bar, volatile LAS unsigned* st) {
    XcdBarrier b; b.bar = bar; b.x = xb_xcc_id(); b.st = st;
    if (threadIdx.x == 0) (void)xb_add(&bar[XB_XCNT(b.x)], 1u);
    return b;
}
__device__ __forceinline__ void xcd_barrier_complete(unsigned* bar, unsigned x, unsigned& nloc, unsigned& nx) {
    const unsigned G = gridDim.x * gridDim.y * gridDim.z;
    unsigned sum, cnt, mine, sp = 0u;
    for (;;) {
        sum = 0u; cnt = 0u; mine = 0u;
#pragma unroll
        for (unsigned j = 0; j < 16; ++j) { const unsigned c = xb_ld(&bar[XB_XCNT(j)]); sum += c; cnt += (c > 0u) ? 1u : 0u; mine = (j == x) ? c : mine; }
        if (sum == G) break;
        __builtin_amdgcn_s_sleep(1);
        if ((++sp & 255u) == 0u) { if (xb_ld(&bar[XB_TMO])) break; if (sp > XB_SPIN_CAP) { atomicAdd(&bar[XB_TMO], 1u); break; } }
    }
    nloc = mine > 0u ? mine : 1u; nx = cnt > 0u ? cnt : 1u;
}
__device__ __forceinline__ void xcd_barrier(const XcdBarrier& b0) {
    asm volatile("s_waitcnt vmcnt(0)" ::: "memory");
    __syncthreads();
    if (threadIdx.x == 0) {
        XcdBarrier b; b.st = b0.st; b.x = xb_xcc_id();
        unsigned* bar = b0.bar; asm volatile("" : "+s"(bar));
        b.bar = bar;
        __builtin_amdgcn_s_waitcnt(0);
        unsigned nloc = b.st[0], nx = b.st[1];
        if (nloc == 0u) { xcd_barrier_complete(bar, b.x, nloc, nx); b.st[0] = nloc; b.st[1] = nx; }
        const unsigned old = xb_add(&bar[XB_XSUB(b.x)], 1u);
        const unsigned gen = old / nloc;
        if (old + 1u == (gen + 1u) * nloc) {
            __builtin_amdgcn_fence(__ATOMIC_RELEASE, "agent");
            asm volatile("s_waitcnt vmcnt(0)" ::: "memory");
            const unsigned og = xb_add(&bar[XB_TOP], 1u);
            const unsigned tg = og / nx;
            if (og + 1u == (tg + 1u) * nx) xb_add(&bar[XB_TOPGEN], 1u);
            else XB_SPIN(xb_ld(&bar[XB_TOPGEN]) == tg, bar);
            __builtin_amdgcn_fence(__ATOMIC_ACQUIRE, "agent");
            xb_add(&bar[XB_XGEN(b.x)], 1u);
            asm volatile("s_waitcnt vmcnt(0)" ::: "memory");
        } else {
            XB_SPIN(xb_ld(&bar[XB_XGEN(b.x)]) == gen, bar);
            __builtin_amdgcn_fence(__ATOMIC_ACQUIRE, "agent");
            asm volatile("s_waitcnt vmcnt(0)" ::: "memory");
        }
    }
    __syncthreads();
}

#if MEGA
__global__ void __launch_bounds__(512, 2) k_mega(Params p) {
  cg::grid_group grid = cg::this_grid();
  volatile LAS unsigned* st = (volatile LAS unsigned*)(g_smem + 155648);
  if (threadIdx.x == 0) { st[0] = 0u; st[1] = 0u; }
  __syncthreads();
  XcdBarrier xb = xcd_barrier_post((unsigned*)(p.ws + WS_BAR), st);
#define GSYNC() xcd_barrier(xb)
#ifndef PROBE_PH
#define PROBE_PH -1
#define PROBE_L 0
#endif
#define PHASE(ph, l, SYNC) do { unsigned long long _t0 = 0; const bool _pr = (PROBE_PH == (ph)) && (PROBE_L == (l)); \
    if (_pr) _t0 = __builtin_amdgcn_s_memrealtime(); \
    run_phase(p, (ph), (l)); SYNC; \
    if (_pr) { unsigned long long _t1 = __builtin_amdgcn_s_memrealtime(); unsigned long long _d = (_t1 - _t0) * 4ull; \
      while (__builtin_amdgcn_s_memrealtime() - _t1 < _d) __builtin_amdgcn_s_sleep(8); } } while (0)
  PHASE(0, 0, GSYNC());
  if (p.use_cg_sync) grid.sync();
  PHASE(1, 0, GSYNC());
  const bool split_ok = (gridDim.x == 256);
  PHASE(2, 0, GSYNC());
#pragma unroll 1
  for (int l = 0; l < 4; ++l) {
    PHASE(3, l, GSYNC());
    if ((l & 1) == 0) {
      PHASE(4, l, GSYNC());
      PHASE(5, l, GSYNC());
    }
    if (l == 3) { PHASE(6, l, GSYNC()); run_phase(p, 1, 4); }
    else if ((l & 1) == 0 && split_ok) {
      PHASE(9, l, GSYNC());
      PHASE(10, l, GSYNC());
      PHASE(11, l, GSYNC());
    } else {
      PHASE(6, l, GSYNC());
      PHASE(2, l + 1, GSYNC());
    }
  }
}
#endif

extern "C" void kernel_launch(void* const* d_in, const int* in_sizes, int n_in, void* d_out, int out_size, void* d_ws, size_t ws_size, hipStream_t stream) {
  Params p{};
  p.x_prompt = (const float*)d_in[0]; p.x_sample = (const float*)d_in[1]; p.c = (const float*)d_in[2]; p.state_gla = (const float*)d_in[3];
  p.c_ctx = (const float*)d_in[4]; p.w_ada = (const float*)d_in[5]; p.b_ada = (const float*)d_in[6]; p.norm_g = (const float*)d_in[7];
  p.w_in_even = (const float*)d_in[8]; p.w_in_odd = (const float*)d_in[9]; p.w_out = (const float*)d_in[10]; p.w_gk = (const float*)d_in[11];
  p.b_gk = (const float*)d_in[12]; p.gla_norm_g = (const float*)d_in[13]; p.sgu_norm_g = (const float*)d_in[14]; p.w_s = (const float*)d_in[15];
  p.b_s = (const float*)d_in[16]; p.w_pool = (const float*)d_in[17]; p.pool_scale = (const float*)d_in[18]; p.w_conv = (const float*)d_in[19];
  p.final_norm_g = (const float*)d_in[20];
  p.out = (float*)d_out; p.ws = (char*)d_ws; p.use_cg_sync = 0; p.pad_ = 0;
#if MEGA
  static int grid_blocks = 0;
  if (!grid_blocks) {
    int dev = 0, cus = 0, per_cu = 0;
    hipGetDevice(&dev);
    hipDeviceGetAttribute(&cus, hipDeviceAttributeMultiprocessorCount, dev);
    hipOccupancyMaxActiveBlocksPerMultiprocessor(&per_cu, k_mega, 512, 0);
    if (per_cu < 1) per_cu = 1;
    grid_blocks = cus;
  }
  hipMemsetAsync((char*)d_ws + WS_BAR, 0, 16384, stream);
  void* args[] = {&p};
  hipError_t e = hipLaunchCooperativeKernel((void*)k_mega, dim3(grid_blocks), dim3(512), args, 0, stream);
  if (e != hipSuccess) fprintf(stderr, "cooperative launch failed: %s (grid %d)\n", hipGetErrorString(e), grid_blocks);
#else
  const int G = 256;
  k_phase<0><<<G, 512, 0, stream>>>(p, 0);
  k_phase<1><<<G, 512, 0, stream>>>(p, 0);
  for (int l = 0; l < 4; ++l) {
    k_phase<2><<<G, 512, 0, stream>>>(p, l);
    k_phase<3><<<G, 512, 0, stream>>>(p, l);
    if ((l & 1) == 0) { k_phase<4><<<G, 512, 0, stream>>>(p, l); k_phase<5><<<G, 512, 0, stream>>>(p, l); }
    k_phase<6><<<G, 512, 0, stream>>>(p, l);
    k_phase<1><<<G, 512, 0, stream>>>(p, l + 1);
  }
#endif
}
```

```cpp
#include <hip/hip_runtime.h>
#include <hip/hip_cooperative_groups.h>
#include <stdint.h>
#include <stdio.h>
namespace cg = cooperative_groups;

#ifndef MEGA
#define MEGA 1
#endif

typedef unsigned short bf16_t;
typedef short bf16x8 __attribute__((ext_vector_type(8)));
typedef float f32x4 __attribute__((ext_vector_type(4)));
typedef unsigned u32x4 __attribute__((ext_vector_type(4)));
typedef unsigned u32x2 __attribute__((ext_vector_type(2)));

constexpr int NTOK = 24576;
constexpr int NPROMPT = 8192;
constexpr int DM = 1024;
constexpr int ZS_E = 3104, ZS_O = 3104, NPAD_E = 3328;
constexpr float EPS = 1e-6f;
constexpr int LDS_BYTES = 155648 + 16;
constexpr int NCH = 192;

constexpr size_t WS_ADA = 0;
constexpr size_t WS_DEC = 262144;
constexpr size_t WS_BAR = 720896;
constexpr size_t WS_WPT = 786432;
constexpr size_t WS_WINE = 1048576;
constexpr size_t WS_WINO = WS_WINE + 2ull * 3328 * 1024 * 2;
constexpr size_t WS_WOUT = WS_WINO + 2ull * 3072 * 1024 * 2;
constexpr size_t WS_SSV = 35651584;
constexpr size_t WS_WSB = WS_SSV + 786432;
constexpr size_t WS_Z = 36700160;
constexpr size_t WS_SSP = 241172480;
constexpr size_t WS_SW = WS_SSP + 1572864;
constexpr size_t WS_ST = WS_SW + 266240;
constexpr size_t WS_H = 190840832;

struct Params {
  const float *x_prompt, *x_sample, *c, *state_gla, *c_ctx, *w_ada, *b_ada, *norm_g, *w_in_even, *w_in_odd, *w_out, *w_gk, *b_gk,
      *gla_norm_g, *sgu_norm_g, *w_s, *b_s, *w_pool, *pool_scale, *w_conv, *final_norm_g;
  float* out;
  char* ws;
  int use_cg_sync;
  int pad_;
};

__shared__ __attribute__((aligned(1024))) char g_smem[LDS_BYTES];

__device__ __forceinline__ float bf2f(bf16_t b) { return __uint_as_float(((uint32_t)b) << 16); }
__device__ __forceinline__ float bflo(uint32_t w) { return __uint_as_float(w << 16); }
__device__ __forceinline__ float bfhi(uint32_t w) { return __uint_as_float(w & 0xffff0000u); }
__device__ __forceinline__ bf16_t f2bf(float f) { uint32_t u = __float_as_uint(f); u += 0x7fffu + ((u >> 16) & 1u); return (bf16_t)(u >> 16); }
__device__ __forceinline__ uint32_t pk2(float lo, float hi) { uint32_t r; asm("v_cvt_pk_bf16_f32 %0, %1, %2" : "=v"(r) : "v"(lo), "v"(hi)); return r; }
__device__ __forceinline__ float silu_f(float x) { return x / (1.f + __expf(-x)); }
__device__ __forceinline__ float logsig(float x) { return fminf(x, 0.f) - __logf(1.f + __expf(-fabsf(x))); }
__device__ __forceinline__ bf16_t bfel(const uint4& v, int e) { uint32_t w = (e >> 1) == 0 ? v.x : (e >> 1) == 1 ? v.y : (e >> 1) == 2 ? v.z : v.w; return (bf16_t)((e & 1) ? (w >> 16) : (w & 0xffffu)); }

__device__ __forceinline__ void chunk_info(int cidx, int& base, int& T, int& C) {
  if (cidx < 64) { C = cidx & 1; T = 256; base = (cidx >> 1) * 256; }
  else { int cs = cidx - 64; C = cs & 31; T = 4096; base = NPROMPT + (cs >> 5) * 4096; }
}
__device__ __forceinline__ int tok_of(int base, int p, bool colm) { return base + (colm ? ((p & 63) * 64 + (p >> 6)) : p); }
__device__ __forceinline__ int cond_of(int row) { return row < NPROMPT ? 0 : 1 + ((row - NPROMPT) >> 12); }

__device__ __forceinline__ int otid() { int t = threadIdx.x; asm volatile("" : "+v"(t)); return t; }
__device__ __forceinline__ int obid() { int b = blockIdx.x; asm volatile("" : "+s"(b)); return b; }
__device__ __forceinline__ int ogdim() { int b = gridDim.x; asm volatile("" : "+s"(b)); return b; }

#define SCHED_FENCE() asm volatile("" ::: "memory")
__device__ __forceinline__ int slot32(int c) { return (c & ~31) | (((c >> 2) & 1) << 4) | (((c >> 3) & 3) << 2) | (c & 3); }
#define MFMA16(a, b, c) __builtin_amdgcn_mfma_f32_16x16x32_bf16((a), (b), (c), 0, 0, 0)

__device__ __forceinline__ int src_col_even(int n) {
  if (n < 1024) return n;
  if (n < 1536) return 1568 + (n - 1024);
  if (n < 2048) return 1024 + (n - 1536);
  if (n < 2560) return 2080 + (n - 2048);
  if (n < 3072) return 2592 + (n - 2560);
  if (n < 3104) return 1536 + (n - 3072);
  return -1;
}
__device__ __forceinline__ int src_col_odd(int n) {
  if (n >= 1024 && n < 1536) return n + 512;
  if (n >= 1536 && n < 2048) return n - 512;
  return n;
}

struct TileP { const float* src; bf16_t* dst; int nsrc, kind, kdim, n0, k0; };
__device__ __forceinline__ void tile_params(const Params& p, int t, TileP& q) {
  int nt, kt; q.kdim = 1024;
  if (t < 1664) { int j = t / 832, r = t % 832; nt = r >> 4; kt = r & 15; q.src = p.w_in_even + (size_t)j * 1024 * 3104; q.nsrc = 3104; q.dst = (bf16_t*)(p.ws + WS_WINE) + (size_t)j * NPAD_E * 1024; q.kind = 0; }
  else if (t < 3200) { int tt = t - 1664; int j = tt / 768, r = tt % 768; nt = r >> 4; kt = r & 15; q.src = p.w_in_odd + (size_t)j * 1024 * 3072; q.nsrc = 3072; q.dst = (bf16_t*)(p.ws + WS_WINO) + (size_t)j * 3072 * 1024; q.kind = 1; }
  else if (t >= 4224) { int tt = t - 4224; int m = tt >> 2, r = tt & 3; nt = r >> 1; kt = r & 1; q.src = p.w_pool + (size_t)m * 16384; q.nsrc = 128; q.dst = (bf16_t*)(p.ws + WS_WPT) + (size_t)m * 16384; q.kind = 2; q.kdim = 128; }
  else { int tt = t - 3200; int l = tt >> 8, r = tt & 255; nt = r >> 4; kt = r & 15; q.src = p.w_out + (size_t)l * 1024 * 1024; q.nsrc = 1024; q.dst = (bf16_t*)(p.ws + WS_WOUT) + (size_t)l * 1024 * 1024; q.kind = 2; }
  q.n0 = nt * 64; q.k0 = kt * 64;
}

__device__ void prep_phase(const Params& p) {
  const int tid = otid();
  char* smem = g_smem;
  constexpr int N_ADA = 192, N_TR = (4224 + 32) / 4, N_WS = 32;
  for (int item = obid(); item < N_ADA + N_TR + N_WS; item += ogdim()) {
    if (item >= N_ADA + N_TR) {
      const int e0 = (item - N_ADA - N_TR) * 4096 + tid * 8;
      const f32x4 a = *(const f32x4*)(p.w_s + e0), b = *(const f32x4*)(p.w_s + e0 + 4);
      uint4 o; o.x = pk2(a[0], a[1]); o.y = pk2(a[2], a[3]); o.z = pk2(b[0], b[1]); o.w = pk2(b[2], b[3]);
      *(uint4*)((bf16_t*)(p.ws + WS_WSB) + e0) = o;
    } else if (item < N_ADA) {
      const int l = item / 48, n0 = (item % 48) * 64;
      float* SC = (float*)smem;
      float* RED = (float*)(smem + 20480);
      for (int i = tid; i < 5120; i += 512) {
        int cb = i >> 10, k = i & 1023;
        float v = cb == 0 ? p.c_ctx[k] : p.c[(cb - 1) * 1024 + k];
        SC[i] = silu_f(v);
      }
      __syncthreads();
      const int col = tid & 63, ks = tid >> 6;
      float a0 = 0, a1 = 0, a2 = 0, a3 = 0, a4 = 0;
      const float* w = p.w_ada + (size_t)l * 1024 * 3072 + n0 + col;
#pragma unroll 8
      for (int kk = 0; kk < 128; ++kk) {
        int k = ks * 128 + kk;
        float wv = w[(size_t)k * 3072];
        a0 += SC[k] * wv; a1 += SC[1024 + k] * wv; a2 += SC[2048 + k] * wv; a3 += SC[3072 + k] * wv; a4 += SC[4096 + k] * wv;
      }
      RED[(ks * 5 + 0) * 64 + col] = a0; RED[(ks * 5 + 1) * 64 + col] = a1; RED[(ks * 5 + 2) * 64 + col] = a2;
      RED[(ks * 5 + 3) * 64 + col] = a3; RED[(ks * 5 + 4) * 64 + col] = a4;
      __syncthreads();
      if (tid < 320) {
        int cb = tid >> 6, cc = tid & 63;
        float s = p.b_ada[l * 3072 + n0 + cc];
        for (int q = 0; q < 8; ++q) s += RED[(q * 5 + cb) * 64 + cc];
        ((float*)(p.ws + WS_ADA))[(l * 5 + cb) * 3072 + n0 + cc] = s;
      }
      __syncthreads();
    } else {
      const int g4 = (item - N_ADA) * 4;
      float* T = (float*)smem;
      f32x4 v[4][2];
      const int c4 = tid & 15, kr = tid >> 4;
#pragma unroll
      for (int q = 0; q < 4; ++q) {
        TileP tp; tile_params(p, g4 + q, tp);
        const int nn = tp.n0 + c4 * 4;
        const int sc = tp.kind == 0 ? src_col_even(nn) : tp.kind == 1 ? src_col_odd(nn) : nn;
        const int scl = sc < 0 ? 0 : sc;
#pragma unroll
        for (int ps = 0; ps < 2; ++ps) {
          const f32x4 ld = *(const f32x4*)(tp.src + (size_t)(tp.k0 + kr + ps * 32) * tp.nsrc + scl);
          v[q][ps] = sc < 0 ? (f32x4){0.f, 0.f, 0.f, 0.f} : ld;
        }
      }
      SCHED_FENCE();
#pragma unroll
      for (int q = 0; q < 4; ++q)
#pragma unroll
        for (int ps = 0; ps < 2; ++ps) {
          float* tq = T + q * 4160 + (kr + ps * 32) * 65 + c4 * 4;
          tq[0] = v[q][ps][0]; tq[1] = v[q][ps][1]; tq[2] = v[q][ps][2]; tq[3] = v[q][ps][3];
        }
      __syncthreads();
#pragma unroll
      for (int q = 0; q < 4; ++q) {
        TileP tp; tile_params(p, g4 + q, tp);
        const float* tq = T + q * 4160;
        const int n = tid >> 3, kc = tid & 7;
        uint4 o;
        o.x = pk2(tq[(kc * 8 + 0) * 65 + n], tq[(kc * 8 + 1) * 65 + n]);
        o.y = pk2(tq[(kc * 8 + 2) * 65 + n], tq[(kc * 8 + 3) * 65 + n]);
        o.z = pk2(tq[(kc * 8 + 4) * 65 + n], tq[(kc * 8 + 5) * 65 + n]);
        o.w = pk2(tq[(kc * 8 + 6) * 65 + n], tq[(kc * 8 + 7) * 65 + n]);
        *(uint4*)(tp.dst + (size_t)(tp.n0 + n) * tp.kdim + tp.k0 + kc * 8) = o;
      }
      __syncthreads();
    }
  }
}

__device__ void final_norm_phase(const Params& p) {
  const int tid = otid(), lane = tid & 63, wid = tid >> 6;
  const bf16_t* H = (const bf16_t*)(p.ws + WS_H);
  const float* SSP = (const float*)(p.ws + WS_SSP);
  f32x4 g[4];
#pragma unroll
  for (int i = 0; i < 2; ++i) { g[2 * i] = *(const f32x4*)(p.final_norm_g + i * 512 + lane * 8); g[2 * i + 1] = *(const f32x4*)(p.final_norm_g + i * 512 + lane * 8 + 4); }
#pragma unroll 2
  for (int row = obid() * 8 + wid; row < NTOK; row += ogdim() * 8) {
    const u32x4 h0 = *(const u32x4*)(H + (size_t)row * DM + lane * 8), h1 = *(const u32x4*)(H + (size_t)row * DM + 512 + lane * 8);
    float ss = SSP[(size_t)row * 16 + (lane & 15)];
    ss += __shfl_xor(ss, 8); ss += __shfl_xor(ss, 4); ss += __shfl_xor(ss, 2); ss += __shfl_xor(ss, 1);
    const float rstd = rsqrtf(ss * (1.f / 1024.f) + EPS);
    float* yo = p.out + (size_t)row * DM + lane * 8;
    *(f32x4*)(yo) = (f32x4){bflo(h0[0]) * rstd * g[0][0], bfhi(h0[0]) * rstd * g[0][1], bflo(h0[1]) * rstd * g[0][2], bfhi(h0[1]) * rstd * g[0][3]};
    *(f32x4*)(yo + 4) = (f32x4){bflo(h0[2]) * rstd * g[1][0], bfhi(h0[2]) * rstd * g[1][1], bflo(h0[3]) * rstd * g[1][2], bfhi(h0[3]) * rstd * g[1][3]};
    *(f32x4*)(yo + 512) = (f32x4){bflo(h1[0]) * rstd * g[2][0], bfhi(h1[0]) * rstd * g[2][1], bflo(h1[1]) * rstd * g[2][2], bfhi(h1[1]) * rstd * g[2][3]};
    *(f32x4*)(yo + 516) = (f32x4){bflo(h1[2]) * rstd * g[3][0], bfhi(h1[2]) * rstd * g[3][1], bflo(h1[3]) * rstd * g[3][2], bfhi(h1[3]) * rstd * g[3][3]};
  }
}

__device__ void norm_phase(const Params& p, int l) {
  const int tid = otid(), lane = tid & 63, wid = tid >> 6;
  const float* ada = (const float*)(p.ws + WS_ADA);
  bf16_t* H = (bf16_t*)(p.ws + WS_H);
  float* SSP = (float*)(p.ws + WS_SSP);
  f32x4 gq[4];
#pragma unroll
  for (int i = 0; i < 4; ++i) gq[i] = *(const f32x4*)((l < 4 ? p.norm_g + l * 1024 : p.final_norm_g) + i * 256 + lane * 4);
  for (int row = obid() * 8 + wid; row < NTOK; row += ogdim() * 8) {
    const float* src = (l == 0) ? (row < NPROMPT ? p.x_prompt + (size_t)row * DM : p.x_sample + (size_t)(row - NPROMPT) * DM) : p.out + (size_t)row * DM;
    f32x4 x[4], sq[4];
    float ss = 0.f;
    {
      const float* sh1 = ada + ((l < 4 ? l : 0) * 5 + cond_of(row)) * 3072 + 1024;
#pragma unroll
      for (int i = 0; i < 4; ++i) { x[i] = *(const f32x4*)(src + i * 256 + lane * 4); sq[i] = *(const f32x4*)(sh1 + i * 256 + lane * 4); }
    }
#pragma unroll
    for (int i = 0; i < 4; ++i) ss += x[i][0] * x[i][0] + x[i][1] * x[i][1] + x[i][2] * x[i][2] + x[i][3] * x[i][3];
#pragma unroll
    for (int m = 32; m >= 1; m >>= 1) ss += __shfl_xor(ss, m);
    if (l < 4) {
      const int cb = cond_of(row);
      const float* sh = ada + (l * 5 + cb) * 3072;
      if (lane < 16) SSP[(size_t)row * 16 + lane] = lane == 0 ? ss : 0.f;
#pragma unroll
      for (int i = 0; i < 4; ++i) {
        const int idx = i * 256 + lane * 4;
        const f32x4 g = gq[i], s1 = sq[i];
        uint2 o; o.x = pk2(x[i][0] * g[0] * (1.f + s1[0]), x[i][1] * g[1] * (1.f + s1[1])); o.y = pk2(x[i][2] * g[2] * (1.f + s1[2]), x[i][3] * g[3] * (1.f + s1[3]));
        *(uint2*)(H + (size_t)row * DM + idx) = o;
      }
    } else {
      const float rstd = rsqrtf(ss * (1.f / 1024.f) + EPS);
#pragma unroll
      for (int i = 0; i < 4; ++i) {
        const int idx = i * 256 + lane * 4;
        const f32x4 g = gq[i];
        f32x4 y = {x[i][0] * rstd * g[0], x[i][1] * rstd * g[1], x[i][2] * rstd * g[2], x[i][3] * rstd * g[3]};
        *(f32x4*)(p.out + (size_t)row * DM + idx) = y;
      }
    }
  }
  if (l == 0) {
    float* SW = (float*)(p.ws + WS_SW);
    for (int item = obid(); item < 4 * 52; item += ogdim()) {
      const int ll = item / 52, n0 = (item % 52) * 64, jj = ll >> 1;
      const int ncols = (ll & 1) ? 3072 : NPAD_E;
      if (n0 >= ncols) continue;
      const bf16_t* Wt = (ll & 1) ? (const bf16_t*)(p.ws + WS_WINO) + (size_t)jj * 3072 * 1024 : (const bf16_t*)(p.ws + WS_WINE) + (size_t)jj * NPAD_E * 1024;
      const int n = n0 + (tid >> 3), kp = tid & 7;
      const bf16_t* wr = Wt + (size_t)n * 1024 + kp * 128;
      float a[5] = {0.f, 0.f, 0.f, 0.f, 0.f};
#pragma unroll 4
      for (int c = 0; c < 16; ++c) {
        uint4 w = *(const uint4*)(wr + c * 8);
        float wv[8] = {bflo(w.x), bfhi(w.x), bflo(w.y), bfhi(w.y), bflo(w.z), bfhi(w.z), bflo(w.w), bfhi(w.w)};
#pragma unroll
        for (int cb = 0; cb < 5; ++cb) {
          const float* sh = ada + (ll * 5 + cb) * 3072 + kp * 128 + c * 8;
          f32x4 s0 = *(const f32x4*)sh, s1 = *(const f32x4*)(sh + 4);
          a[cb] += wv[0] * s0[0] + wv[1] * s0[1] + wv[2] * s0[2] + wv[3] * s0[3] + wv[4] * s1[0] + wv[5] * s1[1] + wv[6] * s1[2] + wv[7] * s1[3];
        }
      }
#pragma unroll
      for (int cb = 0; cb < 5; ++cb) { a[cb] += __shfl_xor(a[cb], 1); a[cb] += __shfl_xor(a[cb], 2); a[cb] += __shfl_xor(a[cb], 4); }
      if (kp == 0) {
#pragma unroll
        for (int cb = 0; cb < 5; ++cb) SW[(ll * 5 + cb) * NPAD_E + n] = a[cb];
      }
    }
  }
}

namespace pg8 {
#define PG8_LAS __attribute__((address_space(3)))
constexpr int BM = 256, BK = 64, HALF = 128, HTB = HALF * BK * 2, NXCD = 8, WGM = 8;
__device__ __forceinline__ int lds_byte(int r, int c) { const int st = (r >> 4) * 2 + (c >> 5), rr = r & 15, cc = c & 31, ob = rr * 64 + cc * 2; return st * 1024 + (ob ^ (((ob >> 9) & 1) << 5)); }
__device__ __forceinline__ void stage_rc(int b, int& R, int& C) { const int st = b / 1024, sb = b % 1024, swz = sb ^ (((sb >> 9) & 1) << 5); R = (st >> 1) * 16 + swz / 64; C = (st & 1) * 32 + (swz % 64) / 2; }
__device__ __forceinline__ int perm32(int rho) { const int n = rho >> 4, i = rho & 15; return 8 * (i >> 2) + 4 * n + (i & 3); }
struct Unit { int pm, pn; };
struct StaticOrder {
    int nM, nN, nwg, G, c, mode;
    __device__ void init(int M, int N, int G_, int c_, int mode_) { nM = M / BM; nN = N / BM; nwg = nM * nN; G = G_; c = c_; mode = mode_; }
    __device__ bool next(int i, Unit& u) const {
        if (mode != 0) {
            const int x = c & 7, off = c >> 3;
            if (mode == 1) { if (i > 0) return false; u.pm = 8 * x + (off & 7); u.pn = off >> 3; return true; }
            if (mode == 2) { if (i > 0 || off >= 16) return false; u.pm = 64 + 4 * x + (off & 3); u.pn = off >> 2; return true; }
            if (mode == 3) { if (i > 0 || off < 16) return false; const int o2 = off - 16; u.pm = 8 * x + (o2 & 7); u.pn = o2 >> 3; return true; }
            const int idx = off + 32 * i, n1 = 8 * (nN - 2);
            if (idx < n1) { u.pm = 8 * x + (idx & 7); u.pn = 2 + (idx >> 3); return true; }
            const int idx2 = idx - n1; if (idx2 >= 4 * nN) return false;
            u.pm = 64 + 4 * x + (idx2 & 3); u.pn = idx2 >> 2; return true;
        }
        const long L = (long)i * G + c; if (L >= nwg) return false;
        int wgid = (int)L; { const int q = nwg / NXCD, r = nwg % NXCD, xcd = wgid % NXCD, off = wgid / NXCD; wgid = (xcd < r ? xcd * (q + 1) : r * (q + 1) + (xcd - r) * q) + off; }
        const int nig = WGM * nN, gid = wgid / nig, fm = gid * WGM, gsz = (nM - fm) < WGM ? (nM - fm) : WGM;
        u.pm = fm + ((wgid % nig) % gsz); u.pn = (wgid % nig) / gsz; return true;
    }
};
}

template <int EPI>
__device__ __forceinline__ void gemm_epilogue(const Params& p, const f32x4 (&acc)[2][2][4][2], const pg8::Unit& u, int wr, int wc, int fr, int fq, int l, int zs) {
  using namespace pg8;
  const int row0 = u.pm * BM + wr * 64 + fr, col0 = u.pn * BM + wc * 32 + 8 * fq;
  if (EPI == 0) {
    bf16_t* Zout = (bf16_t*)(p.ws + WS_Z);
    const float* SSP = (const float*)(p.ws + WS_SSP);
    const float* sw = (const float*)(p.ws + WS_SW) + (l * 5 + cond_of(u.pm * BM)) * NPAD_E + col0;
    f32x4 sv[2][2];
#pragma unroll
    for (int bj = 0; bj < 2; ++bj)
#pragma unroll
      for (int n = 0; n < 2; ++n) sv[bj][n] = *(const f32x4*)(sw + bj * HALF + 4 * n);
    const bool vs_tile = ((l & 1) == 0) && (u.pn == 8 || u.pn == 9);
    f32x4 qv[2][4];
#pragma unroll
    for (int ai = 0; ai < 2; ++ai)
#pragma unroll
      for (int m = 0; m < 4; ++m) qv[ai][m] = *(const f32x4*)(SSP + (size_t)(row0 + ai * HALF + m * 16) * 16 + fq * 4);
#pragma unroll
    for (int ai = 0; ai < 2; ++ai)
#pragma unroll
      for (int m = 0; m < 4; ++m) {
        const int row = row0 + ai * HALF + m * 16;
        float ss = (qv[ai][m][0] + qv[ai][m][1]) + (qv[ai][m][2] + qv[ai][m][3]);
        ss += __shfl_xor(ss, 16); ss += __shfl_xor(ss, 32);
        const float rstd = rsqrtf(ss * (1.f / 1024.f) + EPS);
        bf16_t* rowp = Zout + (size_t)row * zs + col0;
        float vss = 0.f;
#pragma unroll
        for (int bj = 0; bj < 2; ++bj) {
          if (col0 + bj * HALF < zs) {
            const f32x4 v0 = acc[ai][bj][m][0], v1 = acc[ai][bj][m][1], s0 = sv[bj][0], s1 = sv[bj][1];
            const f32x4 z0 = {v0[0] * rstd + s0[0], v0[1] * rstd + s0[1], v0[2] * rstd + s0[2], v0[3] * rstd + s0[3]};
            const f32x4 z1 = {v1[0] * rstd + s1[0], v1[1] * rstd + s1[1], v1[2] * rstd + s1[2], v1[3] * rstd + s1[3]};
            uint4 w; w.x = pk2(z0[0], z0[1]); w.y = pk2(z0[2], z0[3]); w.z = pk2(z1[0], z1[1]); w.w = pk2(z1[2], z1[3]);
            *(uint4*)(rowp + bj * HALF) = w;
            vss += ((z0[0] * z0[0] + z0[1] * z0[1]) + (z0[2] * z0[2] + z0[3] * z0[3])) + ((z1[0] * z1[0] + z1[1] * z1[1]) + (z1[2] * z1[2] + z1[3] * z1[3]));
          }
        }
        if (vs_tile) {
          vss += __shfl_xor(vss, 16); vss += __shfl_xor(vss, 32);
          if (fq == 0) ((float*)(p.ws + WS_SSV))[(size_t)row * 8 + (u.pn - 8) * 4 + wc] = vss;
        }
      }
  } else {
    const int cb = cond_of(u.pm * BM);
    const float* gate = (const float*)(p.ws + WS_ADA) + (l * 5 + cb) * 3072 + 2048 + col0;
    f32x4 gv[2][2], gs[2][2], rc[2][2];
    const bool nxt = l < 3;
    const float* ng = p.norm_g + (nxt ? l + 1 : 0) * 1024 + col0;
    const float* nsc = (const float*)(p.ws + WS_ADA) + ((nxt ? l + 1 : 0) * 5 + cb) * 3072 + 1024 + col0;
    const float* cg_ = p.norm_g + l * 1024 + col0;
    const float* csc = (const float*)(p.ws + WS_ADA) + (l * 5 + cb) * 3072 + 1024 + col0;
#pragma unroll
    for (int bj = 0; bj < 2; ++bj)
#pragma unroll
      for (int n = 0; n < 2; ++n) {
        gv[bj][n] = *(const f32x4*)(gate + bj * HALF + 4 * n);
        { const f32x4 a = *(const f32x4*)(ng + bj * HALF + 4 * n), b = *(const f32x4*)(nsc + bj * HALF + 4 * n);
          gs[bj][n] = nxt ? (f32x4){a[0] * (1.f + b[0]), a[1] * (1.f + b[1]), a[2] * (1.f + b[2]), a[3] * (1.f + b[3])} : (f32x4){1.f, 1.f, 1.f, 1.f}; }
        { const f32x4 a = *(const f32x4*)(cg_ + bj * HALF + 4 * n), b = *(const f32x4*)(csc + bj * HALF + 4 * n);
          rc[bj][n] = (f32x4){1.f / (a[0] * (1.f + b[0])), 1.f / (a[1] * (1.f + b[1])), 1.f / (a[2] * (1.f + b[2])), 1.f / (a[3] * (1.f + b[3]))}; }
      }
    bf16_t* Hn = (bf16_t*)(p.ws + WS_H);
    float* SSP = (float*)(p.ws + WS_SSP);
#pragma unroll
    for (int am = 0; am < 4; ++am) {
      const int ai = am >> 1;
      u32x4 hq[2][2];
#pragma unroll
      for (int mm = 0; mm < 2; ++mm)
#pragma unroll
        for (int bj = 0; bj < 2; ++bj) hq[mm][bj] = *(const u32x4*)(Hn + (size_t)(row0 + ai * HALF + ((am & 1) * 2 + mm) * 16) * DM + col0 + bj * HALF);
#pragma unroll
      for (int mm = 0; mm < 2; ++mm) {
        const int m = (am & 1) * 2 + mm;
        const int row = row0 + ai * HALF + m * 16;
        float ss = 0.f;
#pragma unroll
        for (int bj = 0; bj < 2; ++bj) {
          const u32x4 hv = hq[mm][bj];
          f32x4 xv[2], o[2];
          xv[0] = (f32x4){bflo(hv[0]) * rc[bj][0][0], bfhi(hv[0]) * rc[bj][0][1], bflo(hv[1]) * rc[bj][0][2], bfhi(hv[1]) * rc[bj][0][3]};
          xv[1] = (f32x4){bflo(hv[2]) * rc[bj][1][0], bfhi(hv[2]) * rc[bj][1][1], bflo(hv[3]) * rc[bj][1][2], bfhi(hv[3]) * rc[bj][1][3]};
#pragma unroll
          for (int n = 0; n < 2; ++n) {
            const f32x4 a = acc[ai][bj][m][n], g = gv[bj][n];
            o[n] = (f32x4){xv[n][0] + g[0] * a[0], xv[n][1] + g[1] * a[1], xv[n][2] + g[2] * a[2], xv[n][3] + g[3] * a[3]};
            ss += (o[n][0] * o[n][0] + o[n][1] * o[n][1]) + (o[n][2] * o[n][2] + o[n][3] * o[n][3]);
          }
          const f32x4 s0 = gs[bj][0], s1 = gs[bj][1];
          uint4 w; w.x = pk2(o[0][0] * s0[0], o[0][1] * s0[1]); w.y = pk2(o[0][2] * s0[2], o[0][3] * s0[3]);
          w.z = pk2(o[1][0] * s1[0], o[1][1] * s1[1]); w.w = pk2(o[1][2] * s1[2], o[1][3] * s1[3]);
          *(uint4*)(Hn + (size_t)row * DM + col0 + bj * HALF) = w;
        }
        ss += __shfl_xor(ss, 16); ss += __shfl_xor(ss, 32);
        if (fq == 0) SSP[(size_t)row * 16 + u.pn * 4 + wc] = ss;
      }
    }
  }
}

template <int EPI>
__device__ __forceinline__ void gemm_phase(const Params& p, const bf16_t* __restrict__ gA, int lda, const bf16_t* __restrict__ gBt, int nN, int l, int zs, int mode) {
    using namespace pg8;
    constexpr int K = 1024, nt = K / BK;
    PG8_LAS unsigned char* lds = (PG8_LAS unsigned char*)g_smem;
    const int tid = otid(), wid = __builtin_amdgcn_readfirstlane(tid >> 6), lane = tid & 63, wr = wid >> 2, wc = wid & 3, fr = lane & 15, fq = lane >> 4;
    StaticOrder S; S.init(NTOK, nN * BM, ogdim(), obid(), mode);
    unsigned voffA[2], voffB[2];
#pragma unroll
    for (int i = 0; i < 2; ++i) { int R, C; stage_rc(tid * 16 + i * 8192, R, C); const int Rb = (R & ~31) + perm32(R & 31);
        voffA[i] = (unsigned)(R * lda + C) * 2u; voffB[i] = (unsigned)(Rb * K + C) * 2u; }
    const size_t kstep = (size_t)(BK * 2);
    const size_t hstepA = (size_t)HALF * lda * 2, tstepA = 2 * hstepA;
    const size_t hstepB = (size_t)HALF * K * 2, tstepB = 2 * hstepB;
    const unsigned ldsw = (unsigned)wid * 1024u;
    const int aoff = lds_byte(wr * 64 + fr, fq * 8), boff = lds_byte(wc * 32 + fr, fq * 8);
#define PG8_SA(b, h) (((b) * 2 + (h)) * HTB)
#define PG8_SB(b, h) ((4 + (b) * 2 + (h)) * HTB)
#define PG8_STAGE(bufoff, gbase, voff) do { _Pragma("unroll") for (int _i = 0; _i < 2; ++_i) \
        __builtin_amdgcn_global_load_lds((const unsigned*)((const char*)(gbase) + (voff)[_i]), (PG8_LAS unsigned*)(lds + (bufoff) + ldsw + _i * 8192), 16, 0, 0); } while (0)
#define PG8_LDA(dst, b, h) do { _Pragma("unroll") for (int m = 0; m < 4; ++m) _Pragma("unroll") for (int k = 0; k < 2; ++k) dst[m][k] = *(const PG8_LAS bf16x8*)(lds + PG8_SA(b, h) + aoff + m * 2048 + k * 1024); } while (0)
#define PG8_LDB(dst, b, h) do { _Pragma("unroll") for (int n = 0; n < 2; ++n) _Pragma("unroll") for (int k = 0; k < 2; ++k) dst[n][k] = *(const PG8_LAS bf16x8*)(lds + PG8_SB(b, h) + boff + n * 2048 + k * 1024); } while (0)
#define PG8_MMA(ai, bj, At, Bt) do { __builtin_amdgcn_s_setprio(1); _Pragma("unroll") for (int m = 0; m < 4; ++m) _Pragma("unroll") for (int n = 0; n < 2; ++n) _Pragma("unroll") for (int k = 0; k < 2; ++k) \
        acc[ai][bj][m][n] = __builtin_amdgcn_mfma_f32_16x16x32_bf16(Bt[n][k], At[m][k], acc[ai][bj][m][n], 0, 0, 0); __builtin_amdgcn_s_setprio(0); } while (0)
#define PG8_WAIT_V(n) asm volatile("s_waitcnt vmcnt(" #n ")" ::: "memory")
#define PG8_WAIT_L(n) asm volatile("s_waitcnt lgkmcnt(" #n ")" ::: "memory")
#define PG8_BAR __builtin_amdgcn_s_barrier()
#define PG8_SCHED __builtin_amdgcn_sched_barrier(0)
    Unit cur, nxt; int ui = 0;
    if (!S.next(0, cur)) return;
    f32x4 acc[2][2][4][2];
#pragma unroll
    for (int a = 0; a < 2; ++a)
#pragma unroll
        for (int b = 0; b < 2; ++b)
#pragma unroll
            for (int m = 0; m < 4; ++m)
#pragma unroll
                for (int n = 0; n < 2; ++n) acc[a][b][m][n] = (f32x4){0.f, 0.f, 0.f, 0.f};
    bf16x8 At[4][2], B0[2][2], B1[2][2];
    const char* cA = (const char*)gA + (size_t)cur.pm * tstepA; const char* cB = (const char*)gBt + (size_t)cur.pn * tstepB;
    PG8_STAGE(PG8_SB(0, 0), cB, voffB); PG8_STAGE(PG8_SB(0, 1), cB + hstepB, voffB); PG8_STAGE(PG8_SA(0, 0), cA, voffA); PG8_STAGE(PG8_SA(0, 1), cA + hstepA, voffA);
    if (wr == 1) PG8_BAR;
    PG8_WAIT_V(2); PG8_BAR;
    PG8_STAGE(PG8_SB(1, 0), cB + kstep, voffB); PG8_STAGE(PG8_SA(1, 0), cA + kstep, voffA); PG8_STAGE(PG8_SB(1, 1), cB + hstepB + kstep, voffB);
    PG8_WAIT_V(6); PG8_BAR;
    for (;;) {
        const bool has_next = S.next(ui + 1, nxt);
        const char* nA = has_next ? (const char*)gA + (size_t)nxt.pm * tstepA : cA; const char* nB = has_next ? (const char*)gBt + (size_t)nxt.pn * tstepB : cB;
#pragma unroll 1
        for (int t = 0; t < nt; t += 2) {
            const bool last = (t == nt - 2);
            const char* a1 = cA + (size_t)(t + 1) * kstep;
            const char* a2 = last ? nA : cA + (size_t)(t + 2) * kstep; const char* b2 = last ? nB : cB + (size_t)(t + 2) * kstep;
            const char* a3 = a2 + kstep; const char* b3 = b2 + kstep;
            PG8_LDB(B0, 0, 0); PG8_LDB(B1, 0, 1); PG8_SCHED; PG8_LDA(At, 0, 0); PG8_STAGE(PG8_SA(1, 1), a1 + hstepA, voffA);
            PG8_WAIT_V(8); PG8_WAIT_L(0); PG8_BAR; PG8_MMA(0, 0, At, B0); PG8_MMA(0, 1, At, B1); PG8_BAR; PG8_SCHED;
            PG8_LDA(At, 0, 1); PG8_STAGE(PG8_SB(0, 0), b2, voffB); PG8_STAGE(PG8_SB(0, 1), b2 + hstepB, voffB); PG8_STAGE(PG8_SA(0, 0), a2, voffA);
            PG8_WAIT_V(8); PG8_WAIT_L(0); PG8_BAR; PG8_MMA(1, 0, At, B0); PG8_MMA(1, 1, At, B1); PG8_BAR; PG8_SCHED;
            PG8_LDB(B0, 1, 0); PG8_LDB(B1, 1, 1); PG8_SCHED; PG8_LDA(At, 1, 0); PG8_STAGE(PG8_SA(0, 1), a2 + hstepA, voffA);
            PG8_WAIT_V(8); PG8_WAIT_L(0); PG8_BAR; PG8_MMA(0, 0, At, B0); PG8_MMA(0, 1, At, B1); PG8_BAR; PG8_SCHED;
            PG8_LDA(At, 1, 1); PG8_STAGE(PG8_SB(1, 0), b3, voffB); PG8_STAGE(PG8_SB(1, 1), b3 + hstepB, voffB); PG8_STAGE(PG8_SA(1, 0), a3, voffA);
            PG8_WAIT_V(8); PG8_WAIT_L(0); PG8_BAR; PG8_MMA(1, 0, At, B0); PG8_MMA(1, 1, At, B1); PG8_BAR; PG8_SCHED;
        }
        if (wr == 0) PG8_BAR;
        gemm_epilogue<EPI>(p, acc, cur, wr, wc, fr, fq, l, zs);
        if (!has_next) break;
#pragma unroll
        for (int a = 0; a < 2; ++a)
#pragma unroll
            for (int b = 0; b < 2; ++b)
#pragma unroll
                for (int m = 0; m < 4; ++m)
#pragma unroll
                    for (int n = 0; n < 2; ++n) acc[a][b][m][n] = (f32x4){0.f, 0.f, 0.f, 0.f};
        cur = nxt; cA = nA; cB = nB; ++ui;
        if (wr == 1) PG8_BAR;
    }
    PG8_WAIT_V(0);
    PG8_BAR;
#undef PG8_SA
#undef PG8_SB
#undef PG8_STAGE
#undef PG8_LDA
#undef PG8_LDB
#undef PG8_MMA
#undef PG8_WAIT_V
#undef PG8_WAIT_L
#undef PG8_BAR
#undef PG8_SCHED
}

struct GateW { float wf[16], wb[16], biasf, biasb; };
__device__ __forceinline__ void gatew_load(const Params& p, int j, int h, int lane, GateW& g) {
  const float* wgf = p.w_gk + (size_t)((j * 2 + 0) * 16) * 256 + h * 64 + lane;
  const float* wgb = p.w_gk + (size_t)((j * 2 + 1) * 16) * 256 + h * 64 + lane;
#pragma unroll
  for (int r = 0; r < 16; ++r) { g.wf[r] = wgf[r * 256]; g.wb[r] = wgb[r * 256]; }
  g.biasf = p.b_gk[(j * 2 + 0) * 256 + h * 64 + lane]; g.biasb = p.b_gk[(j * 2 + 1) * 256 + h * 64 + lane];
}
__device__ __forceinline__ void gla_cum(const GateW& gw, const float* LR, float* SEG, int lane, int wid,
                                        float (&bf)[16], float (&bb)[16], float& totf, float& totb) {
  const int k = lane, seg = wid;
  const float (&wf)[16] = gw.wf; const float (&wb)[16] = gw.wb;
  const float biasf = gw.biasf, biasb = gw.biasb;
  float sf = 0.f, sb = 0.f;
#pragma unroll
  for (int i = 0; i < 16; ++i) {
    const f32x4* lr = (const f32x4*)(LR + (seg * 16 + i) * 32);
    float gf = biasf, gb = biasb;
#pragma unroll
    for (int r4 = 0; r4 < 4; ++r4) {
      f32x4 a = lr[r4], b = lr[4 + r4];
      gf += a[0] * wf[r4 * 4 + 0] + a[1] * wf[r4 * 4 + 1] + a[2] * wf[r4 * 4 + 2] + a[3] * wf[r4 * 4 + 3];
      gb += b[0] * wb[r4 * 4 + 0] + b[1] * wb[r4 * 4 + 1] + b[2] * wb[r4 * 4 + 2] + b[3] * wb[r4 * 4 + 3];
    }
    gf = logsig(gf) * (1.f / 16.f); gb = logsig(gb) * (1.f / 16.f);
    sf += gf; bf[i] = sf;
    bb[i] = gb; sb += gb;
  }
  SEG[(0 * 8 + seg) * 64 + k] = sf; SEG[(1 * 8 + seg) * 64 + k] = sb;
  __syncthreads();
  float offf = 0.f, offb = 0.f; totf = 0.f; totb = 0.f;
#pragma unroll
  for (int s = 0; s < 8; ++s) {
    float a = SEG[s * 64 + k], b = SEG[(8 + s) * 64 + k];
    totf += a; totb += b;
    if (s < seg) offf += a;
    if (s > seg) offb += b;
  }
#pragma unroll
  for (int i = 0; i < 16; ++i) bf[i] += offf;
  float run = offb;
#pragma unroll
  for (int i = 15; i >= 0; --i) { run += bb[i]; bb[i] = run; }
}

__device__ __forceinline__ uint4 lr_load(const bf16_t* Z, int base, int C, bool colm, int tid) {
  const int pos = tid >> 2, part = tid & 3;
  const int tok = tok_of(base, C * 128 + pos, colm);
  return *(const uint4*)(Z + (size_t)tok * ZS_E + 3072 + part * 8);
}
__device__ __forceinline__ void lr_store(const uint4 v, float* LR, int tid) {
  const int pos = tid >> 2, part = tid & 3;
  float* d = LR + pos * 32 + part * 8;
  d[0] = bflo(v.x); d[1] = bfhi(v.x); d[2] = bflo(v.y); d[3] = bfhi(v.y); d[4] = bflo(v.z); d[5] = bfhi(v.z); d[6] = bflo(v.w); d[7] = bfhi(v.w);
}
__device__ __forceinline__ void fill_T128(const bf16_t* Z, int zs, int base, int C, bool colm, int col0, char* DST, int ldb, int tid) {
  uint4 v[4];
#pragma unroll
  for (int ii = 0; ii < 4; ++ii) {
    const int id = tid + ii * 512, pos = (id & 15) | (((id >> 6) & 7) << 4), vc = ((id >> 4) & 3) | ((id >> 9) << 2);
    const int tok = tok_of(base, C * 128 + pos, colm);
    v[ii] = *(const uint4*)(Z + (size_t)tok * zs + col0 + vc * 8);
  }
  SCHED_FENCE();
#pragma unroll
  for (int ii = 0; ii < 4; ++ii) {
    const int id = tid + ii * 512, pos = (id & 15) | (((id >> 6) & 7) << 4), vc = ((id >> 4) & 3) | ((id >> 9) << 2);
#pragma unroll
    for (int e = 0; e < 8; ++e) *(bf16_t*)(DST + slot32(vc * 8 + e) * ldb + pos * 2) = bfel(v[ii], e);
  }
}

__device__ __forceinline__ void m1_gla_item(const Params& p, int l, int item, const GateW& gw) {
  char* smem = g_smem;
  const int tid = otid(), lane = tid & 63, wid = tid >> 6, fr = lane & 15, fq = lane >> 4;
  const int cidx = item >> 2, h = item & 3, j = l >> 1;
  int base, T, C; chunk_info(cidx, base, T, C);
  const bool colm = (l >= 2) && (T == 4096);
  const bf16_t* Z = (const bf16_t*)(p.ws + WS_Z);
  float* LR = (float*)smem; float* SEG = (float*)(smem + 16384); char* KT = smem + 20480; char* VT = smem + 55296;
  bf16_t* ST = (bf16_t*)(p.ws + WS_ST); float* DEC = (float*)(p.ws + WS_DEC);
  char* KQ = smem + 90112;
  {
    const uint4 lrv = lr_load(Z, base, C, colm, tid);
    u32x4 kq[2];
#pragma unroll
    for (int ii = 0; ii < 2; ++ii) {
      const int id = tid + ii * 512, pos = id >> 3, c = id & 7;
      const int tok = tok_of(base, C * 128 + pos, colm);
      kq[ii] = *(const u32x4*)(Z + (size_t)tok * ZS_E + 256 + h * 64 + c * 8);
    }
    SCHED_FENCE();
    lr_store(lrv, LR, tid);
#pragma unroll
    for (int ii = 0; ii < 2; ++ii) { const int id = tid + ii * 512, pos = id >> 3, c = id & 7; *(u32x4*)(KQ + pos * 144 + c * 16) = kq[ii]; }
  }
  fill_T128(Z, ZS_E, base, C, colm, 512 + h * 128, VT, 272, tid);
  __syncthreads();
  float bf[16], bb[16], totf, totb;
  gla_cum(gw, LR, SEG, lane, wid, bf, bb, totf, totb);
  {
    const int k = lane, seg = wid;
#pragma unroll
    for (int i = 0; i < 16; ++i) {
      const int pos = seg * 16 + i;
      const float kv = bf2f(*(const bf16_t*)(KQ + pos * 144 + k * 2));
      *(bf16_t*)(KT + k * 272 + pos * 2) = f2bf(kv * __expf(totf - bf[i]));
      *(bf16_t*)(KT + 17408 + k * 272 + pos * 2) = f2bf(kv * __expf(totb - bb[i]));
    }
    if (seg == 0) {
      DEC[((cidx * 4 + h) * 2 + 0) * 64 + k] = __expf(totf);
      DEC[((cidx * 4 + h) * 2 + 1) * 64 + k] = __expf(totb);
    }
  }
  __syncthreads();
  {
    const int dir = wid >> 2, kblk = wid & 3;
    f32x4 acc[8];
#pragma unroll
    for (int n = 0; n < 8; ++n) acc[n] = (f32x4){0.f, 0.f, 0.f, 0.f};
#pragma unroll
    for (int kb = 0; kb < 4; ++kb) {
      bf16x8 a = *(const bf16x8*)(KT + dir * 17408 + (kblk * 16 + fr) * 272 + (kb * 32 + fq * 8) * 2);
#pragma unroll
      for (int n = 0; n < 8; ++n) {
        bf16x8 b = *(const bf16x8*)(VT + (n * 16 + fr) * 272 + (kb * 32 + fq * 8) * 2);
        acc[n] = MFMA16(b, a, acc[n]);
      }
    }
    bf16_t* dst = ST + (size_t)((cidx * 4 + h) * 2 + dir) * 8192 + (kblk * 16 + fr) * 128 + fq * 8;
#pragma unroll
    for (int t = 0; t < 4; ++t) {
      uint4 o; o.x = pk2(acc[2 * t][0], acc[2 * t][1]); o.y = pk2(acc[2 * t][2], acc[2 * t][3]); o.z = pk2(acc[2 * t + 1][0], acc[2 * t + 1][1]); o.w = pk2(acc[2 * t + 1][2], acc[2 * t + 1][3]);
      *(uint4*)(dst + t * 32) = o;
    }
  }
  __syncthreads();
}

__device__ void sgu_item(const Params& p, int l, int item) {
  char* smem = g_smem;
  const int tid = otid(), lane = tid & 63, wid = tid >> 6, fr = lane & 15, fq = lane >> 4;
  const int cidx = item >> 2, hb = item & 3, j = l >> 1;
  int base, T, C; chunk_info(cidx, base, T, C);
  const bool colm = (l >= 2) && (T == 4096);
  bf16_t* Z = (bf16_t*)(p.ws + WS_Z);
  char* WS = smem; char* VNT = smem + 34816; float* RSTD = (float*)(smem + 69632);
  {
    const bf16_t* w = (const bf16_t*)(p.ws + WS_WSB) + (size_t)(j * 4 + hb) * 16384;
    const float* SSV = (const float*)(p.ws + WS_SSV);
    u32x4 wq[4]; f32x4 s0, s1;
    const int pos = tid & 127;
    {
      const int tok = tok_of(base, C * 128 + pos, colm);
      s0 = *(const f32x4*)(SSV + (size_t)tok * 8); s1 = *(const f32x4*)(SSV + (size_t)tok * 8 + 4);
    }
#pragma unroll
    for (int ii = 0; ii < 4; ++ii) { const int id = tid + ii * 512, i = id >> 4, cc = id & 15; wq[ii] = *(const u32x4*)(w + i * 128 + cc * 8); }
    SCHED_FENCE();
    if (tid < 128) RSTD[pos] = rsqrtf((((s0[0] + s0[1]) + (s0[2] + s0[3])) + ((s1[0] + s1[1]) + (s1[2] + s1[3]))) * (1.f / 512.f) + EPS);
#pragma unroll
    for (int ii = 0; ii < 4; ++ii) { const int id = tid + ii * 512, i = id >> 4, cc = id & 15; *(u32x4*)(WS + i * 272 + cc * 16) = wq[ii]; }
  }
  __syncthreads();
  {
    uint4 vq[4];
#pragma unroll
    for (int ii = 0; ii < 4; ++ii) {
      const int id = tid + ii * 512, pos = (id & 15) | (((id >> 6) & 7) << 4), vc = ((id >> 4) & 3) | ((id >> 9) << 2);
      const int tok = tok_of(base, C * 128 + pos, colm);
      vq[ii] = *(const uint4*)(Z + (size_t)tok * ZS_E + 2048 + hb * 128 + vc * 8);
    }
    SCHED_FENCE();
#pragma unroll
    for (int ii = 0; ii < 4; ++ii) {
      const int id = tid + ii * 512, pos = (id & 15) | (((id >> 6) & 7) << 4), vc = ((id >> 4) & 3) | ((id >> 9) << 2);
      const uint4 v = vq[ii];
      const float rs = RSTD[pos];
      const float* g = p.sgu_norm_g + j * 512 + hb * 128 + vc * 8;
#pragma unroll
      for (int e = 0; e < 8; ++e) *(bf16_t*)(VNT + slot32(vc * 8 + e) * 272 + pos * 2) = f2bf(bf2f(bfel(v, e)) * rs * g[e]);
    }
  }
  __syncthreads();
  {
    const int i0 = wid * 16;
    f32x4 acc[8];
#pragma unroll
    for (int n = 0; n < 8; ++n) acc[n] = (f32x4){0.f, 0.f, 0.f, 0.f};
#pragma unroll
    for (int kb = 0; kb < 4; ++kb) {
      bf16x8 a = *(const bf16x8*)(WS + (i0 + fr) * 272 + (kb * 32 + fq * 8) * 2);
#pragma unroll
      for (int n = 0; n < 8; ++n) {
        bf16x8 b = *(const bf16x8*)(VNT + (n * 16 + fr) * 272 + (kb * 32 + fq * 8) * 2);
        acc[n] = MFMA16(b, a, acc[n]);
      }
    }
    const int i = i0 + fr;
    const int tok = tok_of(base, C * 128 + i, colm);
    const float bs = p.b_s[(j * 4 + hb) * 128 + i];
    bf16_t* zr = Z + (size_t)tok * ZS_E;
    uint4 uq[4], gq[4];
#pragma unroll
    for (int t = 0; t < 4; ++t) { const int d = hb * 128 + t * 32 + fq * 8; uq[t] = *(const uint4*)(zr + 1024 + d); gq[t] = *(const uint4*)(zr + 2560 + d); }
    SCHED_FENCE();
#pragma unroll
    for (int t = 0; t < 4; ++t) {
      const int d = hb * 128 + t * 32 + fq * 8;
      float o[8];
#pragma unroll
      for (int e = 0; e < 8; ++e) o[e] = bf2f(bfel(uq[t], e)) * (acc[2 * t + (e >> 2)][e & 3] + bs) * silu_f(bf2f(bfel(gq[t], e)));
      uint4 ov; ov.x = pk2(o[0], o[1]); ov.y = pk2(o[2], o[3]); ov.z = pk2(o[4], o[5]); ov.w = pk2(o[6], o[7]);
      *(uint4*)(zr + 1024 + d) = ov;
    }
  }
  __syncthreads();
}

template <int NCHK, int BATCH, int NI>
__device__ __forceinline__ void scan_multi(bf16_t* ST, const float* DEC, const int (&cidx0)[NI], const int (&h)[NI], const int (&dir)[NI], const bool (&ok)[NI], const int (&e)[NI], float (&S)[NI]) {
#pragma unroll 1
  for (int s0 = 0; s0 < NCHK; s0 += BATCH) {
    float hv[NI][BATCH], dv[NI][BATCH];
#pragma unroll
    for (int q = 0; q < NI; ++q)
#pragma unroll
      for (int i = 0; i < BATCH; ++i) {
        const int step = s0 + i, Cc = dir[q] == 0 ? step : NCHK - 1 - step;
        const size_t idx = (size_t)(((cidx0[q] + Cc) * 4 + h[q]) * 2 + dir[q]);
        hv[q][i] = bf2f(ST[idx * 8192 + e[q]]); dv[q][i] = DEC[idx * 64 + (e[q] >> 7)];
      }
    SCHED_FENCE();
#pragma unroll
    for (int q = 0; q < NI; ++q)
#pragma unroll
      for (int i = 0; i < BATCH; ++i) {
        const int step = s0 + i, Cc = dir[q] == 0 ? step : NCHK - 1 - step;
        const size_t idx = (size_t)(((cidx0[q] + Cc) * 4 + h[q]) * 2 + dir[q]);
        if (ok[q]) ST[idx * 8192 + e[q]] = f2bf(S[q]);
        S[q] = dv[q][i] * S[q] + hv[q][i];
      }
  }
}
__device__ void m2_phase(const Params& p, int l) {
  const int tid = otid(), j = l >> 1, G = ogdim(), b0 = obid();
  bf16_t* ST = (bf16_t*)(p.ws + WS_ST); const float* DEC = (const float*)(p.ws + WS_DEC);
  for (int item = b0; item < 512; item += 2 * G) {
    int c0[2], hh[2], dd[2], ee[2]; bool ok[2]; float S[2];
#pragma unroll
    for (int q = 0; q < 2; ++q) {
      const int it = item + q * G; ok[q] = it < 512;
      const int itc = ok[q] ? it : item;
      const int chain = itc >> 4, slab = itc & 15, b = chain >> 3;
      hh[q] = (chain >> 1) & 3; dd[q] = chain & 1; ee[q] = slab * 512 + tid; c0[q] = 64 + b * 32;
      S[q] = p.state_gla[((size_t)((b * 2 + j) * 2 + dd[q]) * 4 + hh[q]) * 8192 + ee[q]];
    }
    scan_multi<32, 8, 2>(ST, DEC, c0, hh, dd, ok, ee, S);
  }
  for (int item = b0; item < 4096; item += 4 * G) {
    int c0[4], hh[4], dd[4], ee[4], bb[4]; bool ok[4]; float S[4];
#pragma unroll
    for (int q = 0; q < 4; ++q) {
      const int it = item + q * G; ok[q] = it < 4096;
      const int itc = ok[q] ? it : item;
      const int chain = itc >> 4, slab = itc & 15; bb[q] = chain >> 3;
      hh[q] = (chain >> 1) & 3; dd[q] = chain & 1; ee[q] = slab * 512 + tid; c0[q] = bb[q] * 2;
      S[q] = 0.f;
    }
    scan_multi<2, 2, 4>(ST, DEC, c0, hh, dd, ok, ee, S);
#pragma unroll
    for (int q = 0; q < 4; ++q)
      if (ok[q]) p.out[(size_t)NTOK * DM + ((size_t)((bb[q] * 2 + j) * 2 + dd[q]) * 4 + hh[q]) * 8192 + ee[q]] = S[q];
  }
}

__device__ __forceinline__ void m3_gla_item(const Params& p, int l, int item, const GateW& gw) {
  char* smem = g_smem;
  const int tid = otid(), lane = tid & 63, wid = tid >> 6, fr = lane & 15, fq = lane >> 4;
  const int cidx = item >> 2, h = item & 3, j = l >> 1;
  int base, T, C; chunk_info(cidx, base, T, C);
  const bool colm = (l >= 2) && (T == 4096);
  bf16_t* Z = (bf16_t*)(p.ws + WS_Z);
  char* AT = smem; char* VST = smem + 67584; char* KPf = smem + 67584; char* KPb = smem + 67584 + 18432;
  float* LR = (float*)(smem + 135168); float* SEG = (float*)(smem + 135168 + 16384);
  const bf16_t* ST = (const bf16_t*)(p.ws + WS_ST);
  {
    const uint4 lrv = lr_load(Z, base, C, colm, tid);
    u32x4 qk[4];
#pragma unroll
    for (int ii = 0; ii < 4; ++ii) {
      const int id = tid + ii * 512, pos = id >> 4, c = id & 15;
      const int tok = tok_of(base, C * 128 + pos, colm);
      qk[ii] = *(const u32x4*)(Z + (size_t)tok * ZS_E + (c < 8 ? h * 64 + c * 8 : 256 + h * 64 + (c - 8) * 8));
    }
    SCHED_FENCE();
    lr_store(lrv, LR, tid);
#pragma unroll
    for (int ii = 0; ii < 4; ++ii) { const int id = tid + ii * 512, pos = id >> 4, c = id & 15; *(u32x4*)(AT + pos * 528 + c * 16) = qk[ii]; }
  }
  __syncthreads();
  {
    float bf[16], bb[16], totf, totb;
    gla_cum(gw, LR, SEG, lane, wid, bf, bb, totf, totb);
    const int k = lane, seg = wid;
#pragma unroll
    for (int i = 0; i < 16; ++i) {
      const int pos = seg * 16 + i;
      const float q = bf2f(*(const bf16_t*)(AT + pos * 528 + k * 2)) * 0.125f;
      const float kk = bf2f(*(const bf16_t*)(AT + pos * 528 + 128 + k * 2));
      *(bf16_t*)(AT + pos * 528 + (128 + k) * 2) = f2bf(q * __expf(bf[i]));
      *(bf16_t*)(AT + pos * 528 + (192 + k) * 2) = f2bf(q * __expf(bb[i]));
      *(bf16_t*)(KPf + pos * 144 + k * 2) = f2bf(kk * __expf(-bf[i]));
      *(bf16_t*)(KPb + pos * 144 + k * 2) = f2bf(kk * __expf(-bb[i]));
    }
  }
  __syncthreads();
  const int i0 = wid * 16;
  {
    f32x4 pf[8], pb[8];
#pragma unroll
    for (int n = 0; n < 8; ++n) { pf[n] = (f32x4){0.f, 0.f, 0.f, 0.f}; pb[n] = (f32x4){0.f, 0.f, 0.f, 0.f}; }
#pragma unroll
    for (int kb = 0; kb < 2; ++kb) {
      bf16x8 aqf = *(const bf16x8*)(AT + (i0 + fr) * 528 + (128 + kb * 32 + fq * 8) * 2);
      bf16x8 aqb = *(const bf16x8*)(AT + (i0 + fr) * 528 + (192 + kb * 32 + fq * 8) * 2);
#pragma unroll
      for (int n = 0; n < 8; ++n) {
        bf16x8 bkf = *(const bf16x8*)(KPf + (n * 16 + fr) * 144 + (kb * 32 + fq * 8) * 2);
        bf16x8 bkb = *(const bf16x8*)(KPb + (n * 16 + fr) * 144 + (kb * 32 + fq * 8) * 2);
        pf[n] = MFMA16(bkf, aqf, pf[n]);
        pb[n] = MFMA16(bkb, aqb, pb[n]);
      }
    }
    const int i = i0 + fr;
#pragma unroll
    for (int n = 0; n < 8; ++n) {
      float a[4];
#pragma unroll
      for (int r = 0; r < 4; ++r) { const int jj = n * 16 + fq * 4 + r; a[r] = (jj <= i ? pf[n][r] : 0.f) + (jj >= i ? pb[n][r] : 0.f); }
      uint2 o; o.x = pk2(a[0], a[1]); o.y = pk2(a[2], a[3]);
      *(uint2*)(AT + i * 528 + (n * 16 + fq * 4) * 2) = o;
    }
  }
  __syncthreads();
  fill_T128(Z, ZS_E, base, C, colm, 512 + h * 128, VST, 528, tid);
  {
    u32x2 sq[2][4];
#pragma unroll
    for (int dir = 0; dir < 2; ++dir) {
      const bf16_t* s = ST + (size_t)((cidx * 4 + h) * 2 + dir) * 8192;
#pragma unroll
      for (int ii = 0; ii < 4; ++ii) { const int id = tid + ii * 512, k = id & 63, v4 = id >> 6; sq[dir][ii] = *(const u32x2*)(s + k * 128 + v4 * 4); }
    }
    SCHED_FENCE();
#pragma unroll
    for (int dir = 0; dir < 2; ++dir)
#pragma unroll
      for (int ii = 0; ii < 4; ++ii) {
        const int id = tid + ii * 512, k = id & 63, v4 = id >> 6;
        const unsigned w0 = sq[dir][ii][0], w1 = sq[dir][ii][1];
        char* d0 = VST + slot32(v4 * 4) * 528 + (128 + dir * 64 + k) * 2;
        *(bf16_t*)(d0) = (bf16_t)(w0 & 0xffffu); *(bf16_t*)(d0 + 528) = (bf16_t)(w0 >> 16);
        *(bf16_t*)(d0 + 1056) = (bf16_t)(w1 & 0xffffu); *(bf16_t*)(d0 + 1584) = (bf16_t)(w1 >> 16);
      }
  }
  __syncthreads();
  {
    f32x4 o[8];
#pragma unroll
    for (int n = 0; n < 8; ++n) o[n] = (f32x4){0.f, 0.f, 0.f, 0.f};
#pragma unroll
    for (int kb = 0; kb < 8; ++kb) {
      bf16x8 a = *(const bf16x8*)(AT + (i0 + fr) * 528 + (kb * 32 + fq * 8) * 2);
#pragma unroll
      for (int n = 0; n < 8; ++n) {
        bf16x8 b = *(const bf16x8*)(VST + (n * 16 + fr) * 528 + (kb * 32 + fq * 8) * 2);
        o[n] = MFMA16(b, a, o[n]);
      }
    }
    float ss = 0.f;
#pragma unroll
    for (int n = 0; n < 8; ++n) ss += o[n][0] * o[n][0] + o[n][1] * o[n][1] + o[n][2] * o[n][2] + o[n][3] * o[n][3];
    ss += __shfl_xor(ss, 16); ss += __shfl_xor(ss, 32);
    const float rstd = rsqrtf(ss * (1.f / 128.f) + EPS);
    const int tok = tok_of(base, C * 128 + i0 + fr, colm);
    bf16_t* zr = Z + (size_t)tok * ZS_E;
    uint4 gaq[4]; f32x4 gq[8];
#pragma unroll
    for (int t = 0; t < 4; ++t) {
      gaq[t] = *(const uint4*)(zr + 1536 + h * 128 + t * 32 + fq * 8);
      gq[2 * t] = *(const f32x4*)(p.gla_norm_g + j * 128 + t * 32 + fq * 8); gq[2 * t + 1] = *(const f32x4*)(p.gla_norm_g + j * 128 + t * 32 + fq * 8 + 4);
    }
    SCHED_FENCE();
#pragma unroll
    for (int t = 0; t < 4; ++t) {
      float r[8];
#pragma unroll
      for (int e = 0; e < 8; ++e) r[e] = o[2 * t + (e >> 2)][e & 3] * rstd * gq[2 * t + (e >> 2)][e & 3] * silu_f(bf2f(bfel(gaq[t], e)));
      uint4 ov; ov.x = pk2(r[0], r[1]); ov.y = pk2(r[2], r[3]); ov.z = pk2(r[4], r[5]); ov.w = pk2(r[6], r[7]);
      *(uint4*)(zr + 512 + h * 128 + t * 32 + fq * 8) = ov;
    }
  }
  __syncthreads();
}

__device__ void odd_item(const Params& p, int l, int item) {
  char* smem = g_smem;
  const int tid = otid(), lane = tid & 63, wid = tid >> 6, fr = lane & 15, fq = lane >> 4;
  const int cidx = item >> 2, g = item & 3, j = l >> 1;
  int base, T, C; chunk_info(cidx, base, T, C);
  const bool colm = (l >= 2) && (T == 4096);
  bf16_t* Z = (bf16_t*)(p.ws + WS_Z);
  char* XC = smem; char* PL = smem + 39168; char* WP = smem + 73984;
  const int p0 = C * 128;
  const bool conv_first = ((obid() >> 3) & 1) != 0;
#pragma unroll 1
  for (int pass = 0; pass < 2; ++pass) {
    if ((pass == 0) != conv_first) {
      {
        const bf16_t* w = (const bf16_t*)(p.ws + WS_WPT) + (size_t)(j * 4 + g) * 16384;
        u32x4 xv[5], wv[4];
    #pragma unroll
        for (int ii = 0; ii < 5; ++ii) {
          const int id = min(tid + ii * 512, 144 * 16 - 1), r = id >> 4, cc = id & 15, pos = p0 - 8 + r;
          const int pcl = min(max(pos, 0), T - 1);
          xv[ii] = *(const u32x4*)(Z + (size_t)tok_of(base, pcl, colm) * ZS_O + g * 128 + cc * 8);
        }
    #pragma unroll
        for (int ii = 0; ii < 4; ++ii) { const int id = tid + ii * 512, d = id >> 4, cc = id & 15; wv[ii] = *(const u32x4*)(w + d * 128 + cc * 8); }
        SCHED_FENCE();
    #pragma unroll
        for (int ii = 0; ii < 5; ++ii) {
          const int id = min(tid + ii * 512, 144 * 16 - 1), r = id >> 4, cc = id & 15;
          *(u32x4*)(XC + r * 272 + cc * 16) = xv[ii];
        }
    #pragma unroll
        for (int ii = 0; ii < 4; ++ii) { const int id = tid + ii * 512, d = id >> 4, cc = id & 15; *(u32x4*)(WP + slot32(d) * 272 + cc * 16) = wv[ii]; }
      }
      __syncthreads();
      {
        const int hw = 1 << g;
    #pragma unroll
        for (int ii = 0; ii < 4; ++ii) {
          const int id = tid + ii * 512, t = id >> 4, cc = id & 15, pos = p0 + t;
          const int lo = max(pos - hw, 0), hi = min(pos + hw, T);
          float s[8];
    #pragma unroll
          for (int e = 0; e < 8; ++e) s[e] = 0.f;
          for (int pp = lo; pp < hi; ++pp) {
            uint4 v = *(const uint4*)(XC + (pp - p0 + 8) * 272 + cc * 16);
            s[0] += bflo(v.x); s[1] += bfhi(v.x); s[2] += bflo(v.y); s[3] += bfhi(v.y); s[4] += bflo(v.z); s[5] += bfhi(v.z); s[6] += bflo(v.w); s[7] += bfhi(v.w);
          }
          const float inv = 1.f / (float)(hi - lo);
          uint4 cv = *(const uint4*)(XC + (t + 8) * 272 + cc * 16);
          uint4 o;
          o.x = pk2(s[0] * inv - bflo(cv.x), s[1] * inv - bfhi(cv.x));
          o.y = pk2(s[2] * inv - bflo(cv.y), s[3] * inv - bfhi(cv.y));
          o.z = pk2(s[4] * inv - bflo(cv.z), s[5] * inv - bfhi(cv.z));
          o.w = pk2(s[6] * inv - bflo(cv.w), s[7] * inv - bfhi(cv.w));
          *(uint4*)(PL + t * 272 + cc * 16) = o;
        }
      }
      __syncthreads();
      {
        const int i0 = wid * 16;
        f32x4 acc[8];
    #pragma unroll
        for (int n = 0; n < 8; ++n) acc[n] = (f32x4){0.f, 0.f, 0.f, 0.f};
    #pragma unroll
        for (int kb = 0; kb < 4; ++kb) {
          bf16x8 a = *(const bf16x8*)(PL + (i0 + fr) * 272 + (kb * 32 + fq * 8) * 2);
    #pragma unroll
          for (int n = 0; n < 8; ++n) {
            bf16x8 b = *(const bf16x8*)(WP + (n * 16 + fr) * 272 + (kb * 32 + fq * 8) * 2);
            acc[n] = MFMA16(b, a, acc[n]);
          }
        }
        const int tok = tok_of(base, p0 + i0 + fr, colm);
        bf16_t* zr = Z + (size_t)tok * ZS_O;
        uint4 gcq[4]; f32x4 psq[8];
#pragma unroll
        for (int t = 0; t < 4; ++t) {
          const int d = g * 128 + t * 32 + fq * 8;
          gcq[t] = *(const uint4*)(zr + 512 + d);
          psq[2 * t] = *(const f32x4*)(p.pool_scale + j * 512 + d); psq[2 * t + 1] = *(const f32x4*)(p.pool_scale + j * 512 + d + 4);
        }
        SCHED_FENCE();
#pragma unroll
        for (int t = 0; t < 4; ++t) {
          const int d = g * 128 + t * 32 + fq * 8;
          float r[8];
#pragma unroll
          for (int e = 0; e < 8; ++e) r[e] = acc[2 * t + (e >> 2)][e & 3] * psq[2 * t + (e >> 2)][e & 3] * silu_f(bf2f(bfel(gcq[t], e)));
          uint4 o; o.x = pk2(r[0], r[1]); o.y = pk2(r[2], r[3]); o.z = pk2(r[4], r[5]); o.w = pk2(r[6], r[7]);
          *(uint4*)(zr + 512 + d) = o;
        }
      }
    } else {
      {
        const int cc = tid & 15, ch = g * 128 + cc * 8;
        float w0[8], w1[8], w2[8];
        {
          const float* wp = p.w_conv + (size_t)(j * 3) * 512 + ch;
    #pragma unroll
          for (int e = 0; e < 8; ++e) { w0[e] = wp[e]; w1[e] = wp[512 + e]; w2[e] = wp[1024 + e]; }
        }
    #pragma unroll 1
        for (int pass = 0; pass < 2; ++pass) {
          uint4 xdq[2][3], cdq[2][3], bdq[2], gdq[2];
    #pragma unroll
          for (int uu = 0; uu < 2; ++uu) {
            const int t = (tid >> 4) + (pass * 2 + uu) * 32, pos = p0 + t;
    #pragma unroll
            for (int dd = 0; dd < 3; ++dd) {
              const int pp = pos - 1 + dd;
              const bf16_t* zr = Z + (size_t)tok_of(base, min(max(pp, 0), T - 1), colm) * ZS_O;
              xdq[uu][dd] = *(const uint4*)(zr + 1536 + ch); cdq[uu][dd] = *(const uint4*)(zr + 2048 + ch);
            }
            const bf16_t* zr = Z + (size_t)tok_of(base, pos, colm) * ZS_O;
            bdq[uu] = *(const uint4*)(zr + 1024 + ch); gdq[uu] = *(const uint4*)(zr + 2560 + ch);
          }
    #pragma unroll
          for (int uu = 0; uu < 2; ++uu) {
            const int t = (tid >> 4) + (pass * 2 + uu) * 32, pos = p0 + t;
            float o[8];
    #pragma unroll
            for (int e = 0; e < 8; ++e) {
              float y = 0.f;
    #pragma unroll
              for (int dd = 0; dd < 3; ++dd) {
                const int pp = pos - 1 + dd;
                const float mk = (pp >= 0 && pp < T) ? 1.f : 0.f;
                const float uv = mk * bf2f(bfel(xdq[uu][dd], e)) * bf2f(bfel(cdq[uu][dd], e));
                y += uv * (dd == 0 ? w0[e] : dd == 1 ? w1[e] : w2[e]);
              }
              o[e] = bf2f(bfel(bdq[uu], e)) * y * silu_f(bf2f(bfel(gdq[uu], e)));
            }
            uint4 ov; ov.x = pk2(o[0], o[1]); ov.y = pk2(o[2], o[3]); ov.z = pk2(o[4], o[5]); ov.w = pk2(o[6], o[7]);
            *(uint4*)(Z + (size_t)tok_of(base, pos, colm) * ZS_O + 1024 + ch) = ov;
          }
        }
      }
    }
  }
  __syncthreads();
}

__device__ __forceinline__ void run_phase(const Params& p, int ph, int l) {
  if (ph == 2 || ph == 6 || ph >= 9) {
    int g2mode = -1, g1mode = -1, l1 = l;
    if (ph == 2) g1mode = 0;
    else if (ph == 6) g2mode = 0;
    else if (ph == 9) g2mode = 1;
    else if (ph == 10) { if (obid() < 128) g2mode = 2; else { g1mode = 3; l1 = l + 1; } }
    else { g1mode = 4; l1 = l + 1; }
    if (g2mode >= 0) {
      const bool ev = (l & 1) == 0;
      gemm_phase<1>(p, (const bf16_t*)(p.ws + WS_Z) + 512, ev ? ZS_E : ZS_O, (const bf16_t*)(p.ws + WS_WOUT) + (size_t)l * 1024 * 1024, 4, l, 0, g2mode);
    }
    if (g1mode >= 0) {
      const bool ev = (l1 & 1) == 0; const int j1 = l1 >> 1;
      gemm_phase<0>(p, (const bf16_t*)(p.ws + WS_H), DM,
                    ev ? (const bf16_t*)(p.ws + WS_WINE) + (size_t)j1 * NPAD_E * 1024 : (const bf16_t*)(p.ws + WS_WINO) + (size_t)j1 * 3072 * 1024,
                    ev ? 13 : 12, l1, ev ? ZS_E : ZS_O, g1mode);
    }
    return;
  }
  const bool even = (l & 1) == 0;
  const int j = l >> 1;
  switch (ph) {
    case 0: prep_phase(p); break;
    case 1: if (l == 4) final_norm_phase(p); else norm_phase(p, l); break;
    case 3:
    case 5:
      if (even) {
        GateW gw; int hl = -1;
        const int G = ogdim();
        const bool sgu_first = ((obid() >> 3) & 1) != 0;
#pragma unroll 1
        for (int pass = 0; pass < 2; ++pass) {
          if ((pass == 0) == sgu_first) {
            int k = 0;
            for (int item = obid(); item < 768; item += G, ++k) { if (((k % 3) != 0) == (ph == 5)) sgu_item(p, l, item); }
          } else {
            for (int item = obid(); item < 768; item += G) {
              if ((item & 3) != hl) { hl = item & 3; gatew_load(p, j, hl, otid() & 63, gw); }
              if (ph == 3) m1_gla_item(p, l, item, gw); else m3_gla_item(p, l, item, gw);
            }
          }
        }
      } else {
        for (int item = obid(); item < 768; item += ogdim()) odd_item(p, l, item);
      }
      break;
    case 4: m2_phase(p, l); break;
  }
}

template <int PH> __global__ void __launch_bounds__(512, 2) k_phase(Params p, int l) { run_phase(p, PH, l); }

#define XB_TMO      128
#define XB_XCNT(j)  (256  + 64 * (j))
#define XB_XSUB(j)  (1280 + 64 * (j))
#define XB_XGEN(j)  (2304 + 64 * (j))
#define XB_TOP      3328
#define XB_TOPGEN   3392
#define XCD_BAR_WORDS 3456
#define XB_SPIN_CAP (1u << 18)
#define LAS __attribute__((address_space(3)))
__device__ __forceinline__ unsigned xb_ld(unsigned* p)              { return __hip_atomic_load(p, __ATOMIC_RELAXED, __HIP_MEMORY_SCOPE_AGENT); }
__device__ __forceinline__ unsigned xb_add(unsigned* p, unsigned v) { return __hip_atomic_fetch_add(p, v, __ATOMIC_RELAXED, __HIP_MEMORY_SCOPE_AGENT); }
__device__ __forceinline__ unsigned xb_xcc_id() { return (unsigned)__builtin_amdgcn_s_getreg((3 << 11) | 20) & 0xFu; }
#define XB_SPIN(cond, bar) do { unsigned _sp = 0; while (cond) { __builtin_amdgcn_s_sleep(1); \
    if ((++_sp & 255u) == 0u) { if (xb_ld(&(bar)[XB_TMO])) break; if (_sp > XB_SPIN_CAP) { atomicAdd(&(bar)[XB_TMO], 1u); break; } } } } while (0)
struct XcdBarrier { unsigned* bar; unsigned x; volatile LAS unsigned* st; };
__device__ __forceinline__ XcdBarrier xcd_barrier_post(unsigned* bar, volatile LAS unsigned* st) {
    XcdBarrier b; b.bar = bar; b.x = xb_xcc_id(); b.st = st;
    if (threadIdx.x == 0) (void)xb_add(&bar[XB_XCNT(b.x)], 1u);
    return b;
}
__device__ __forceinline__ void xcd_barrier_complete(unsigned* bar, unsigned x, unsigned& nloc, unsigned& nx) {
    const unsigned G = gridDim.x * gridDim.y * gridDim.z;
    unsigned sum, cnt, mine, sp = 0u;
    for (;;) {
        sum = 0u; cnt = 0u; mine = 0u;
#pragma unroll
        for (unsigned j = 0; j < 16; ++j) { const unsigned c = xb_ld(&bar[XB_XCNT(j)]); sum += c; cnt += (c > 0u) ? 1u : 0u; mine = (j == x) ? c : mine; }
        if (sum == G) break;
        __builtin_amdgcn_s_sleep(1);
        if ((++sp & 255u) == 0u) { if (xb_ld(&bar[XB_TMO])) break; if (sp > XB_SPIN_CAP) { atomicAdd(&bar[XB_TMO], 1u); break; } }
    }
    nloc = mine > 0u ? mine : 1u; nx = cnt > 0u ? cnt : 1u;
}
__device__ __forceinline__ void xcd_barrier(const XcdBarrier& b0) {
    asm volatile("s_waitcnt vmcnt(0)" ::: "memory");
    __syncthreads();
    if (threadIdx.x == 0) {
        XcdBarrier b; b.st = b0.st; b.x = xb_xcc_id();
        unsigned* bar = b0.bar; asm volatile("" : "+s"(bar));
        b.bar = bar;
        __builtin_amdgcn_s_waitcnt(0);
        unsigned nloc = b.st[0], nx = b.st[1];
        if (nloc == 0u) { xcd_barrier_complete(bar, b.x, nloc, nx); b.st[0] = nloc; b.st[1] = nx; }
        const unsigned old = xb_add(&bar[XB_XSUB(b.x)], 1u);
        const unsigned gen = old / nloc;
        if (old + 1u == (gen + 1u) * nloc) {
            __builtin_amdgcn_fence(__ATOMIC_RELEASE, "agent");
            asm volatile("s_waitcnt vmcnt(0)" ::: "memory");
            const unsigned og = xb_add(&bar[XB_TOP], 1u);
            const unsigned tg = og / nx;
            if (og + 1u == (tg + 1u) * nx) xb_add(&bar[XB_TOPGEN], 1u);
            else XB_SPIN(xb_ld(&bar[XB_TOPGEN]) == tg, bar);
            __builtin_amdgcn_fence(__ATOMIC_ACQUIRE, "agent");
            xb_add(&bar[XB_XGEN(b.x)], 1u);
            asm volatile("s_waitcnt vmcnt(0)" ::: "memory");
        } else {
            XB_SPIN(xb_ld(&bar[XB_XGEN(b.x)]) == gen, bar);
            __builtin_amdgcn_fence(__ATOMIC_ACQUIRE, "agent");
            asm volatile("s_waitcnt vmcnt(0)" ::: "memory");
        }
    }
    __syncthreads();
}

#if MEGA
__global__ void __launch_bounds__(512, 2) k_mega(Params p) {
  cg::grid_group grid = cg::this_grid();
  volatile LAS unsigned* st = (volatile LAS unsigned*)(g_smem + 155648);
  if (threadIdx.x == 0) { st[0] = 0u; st[1] = 0u; }
  __syncthreads();
  XcdBarrier xb = xcd_barrier_post((unsigned*)(p.ws + WS_BAR), st);
#define GSYNC() xcd_barrier(xb)
#ifndef PROBE_PH
#define PROBE_PH -1
#define PROBE_L 0
#endif
#define PHASE(ph, l, SYNC) do { unsigned long long _t0 = 0; const bool _pr = (PROBE_PH == (ph)) && (PROBE_L == (l)); \
    if (_pr) _t0 = __builtin_amdgcn_s_memrealtime(); \
    run_phase(p, (ph), (l)); SYNC; \
    if (_pr) { unsigned long long _t1 = __builtin_amdgcn_s_memrealtime(); unsigned long long _d = (_t1 - _t0) * 4ull; \
      while (__builtin_amdgcn_s_memrealtime() - _t1 < _d) __builtin_amdgcn_s_sleep(8); } } while (0)
  PHASE(0, 0, GSYNC());
  if (p.use_cg_sync) grid.sync();
  PHASE(1, 0, GSYNC());
  const bool split_ok = (gridDim.x == 256);
  PHASE(2, 0, GSYNC());
#pragma unroll 1
  for (int l = 0; l < 4; ++l) {
    PHASE(3, l, GSYNC());
    if ((l & 1) == 0) {
      PHASE(4, l, GSYNC());
      PHASE(5, l, GSYNC());
    }
    if (l == 3) { PHASE(6, l, GSYNC()); run_phase(p, 1, 4); }
    else if ((l & 1) == 0 && split_ok) {
      PHASE(9, l, GSYNC());
      PHASE(10, l, GSYNC());
      PHASE(11, l, GSYNC());
    } else {
      PHASE(6, l, GSYNC());
      PHASE(2, l + 1, GSYNC());
    }
  }
}
#endif

extern "C" void kernel_launch(void* const* d_in, const int* in_sizes, int n_in, void* d_out, int out_size, void* d_ws, size_t ws_size, hipStream_t stream) {
  Params p{};
  p.x_prompt = (const float*)d_in[0]; p.x_sample = (const float*)d_in[1]; p.c = (const float*)d_in[2]; p.state_gla = (const float*)d_in[3];
  p.c_ctx = (const float*)d_in[4]; p.w_ada = (const float*)d_in[5]; p.b_ada = (const float*)d_in[6]; p.norm_g = (const float*)d_in[7];
  p.w_in_even = (const float*)d_in[8]; p.w_in_odd = (const float*)d_in[9]; p.w_out = (const float*)d_in[10]; p.w_gk = (const float*)d_in[11];
  p.b_gk = (const float*)d_in[12]; p.gla_norm_g = (const float*)d_in[13]; p.sgu_norm_g = (const float*)d_in[14]; p.w_s = (const float*)d_in[15];
  p.b_s = (const float*)d_in[16]; p.w_pool = (const float*)d_in[17]; p.pool_scale = (const float*)d_in[18]; p.w_conv = (const float*)d_in[19];
  p.final_norm_g = (const float*)d_in[20];
  p.out = (float*)d_out; p.ws = (char*)d_ws; p.use_cg_sync = 0; p.pad_ = 0;
#if MEGA
  static int grid_blocks = 0;
  if (!grid_blocks) {
    int dev = 0, cus = 0, per_cu = 0;
    hipGetDevice(&dev);
    hipDeviceGetAttribute(&cus, hipDeviceAttributeMultiprocessorCount, dev);
    hipOccupancyMaxActiveBlocksPerMultiprocessor(&per_cu, k_mega, 512, 0);
    if (per_cu < 1) per_cu = 1;
    grid_blocks = cus;
  }
  hipMemsetAsync((char*)d_ws + WS_BAR, 0, 16384, stream);
  void* args[] = {&p};
  hipError_t e = hipLaunchCooperativeKernel((void*)k_mega, dim3(grid_blocks), dim3(512), args, 0, stream);
  if (e != hipSuccess) fprintf(stderr, "cooperative launch failed: %s (grid %d)\n", hipGetErrorString(e), grid_blocks);
#else
  const int G = 256;
  k_phase<0><<<G, 512, 0, stream>>>(p, 0);
  k_phase<1><<<G, 512, 0, stream>>>(p, 0);
  for (int l = 0; l < 4; ++l) {
    k_phase<2><<<G, 512, 0, stream>>>(p, l);
    k_phase<3><<<G, 512, 0, stream>>>(p, l);
    if ((l & 1) == 0) { k_phase<4><<<G, 512, 0, stream>>>(p, l); k_phase<5><<<G, 512, 0, stream>>>(p, l); }
    k_phase<6><<<G, 512, 0, stream>>>(p, l);
    k_phase<1><<<G, 512, 0, stream>>>(p, l + 1);
  }
#endif
}
```
